# Optimizing an MI355X kernel written in HIP

```python
import jax, jax.numpy as jnp
from jax import lax
import numpy as np

D_MODEL = 2048
BATCH = 4
SEQ = 8192
DEPTH = 2
DEC_BATCH = 32
DEC_SEQ = 16
PAST_LEN = 1024

CHUNK = 64
HA = 8
DN = 128
DR = 64
DVA = 128
Q_LORA = 512
KV_LORA = 256
Q_BLOCK = 128
HB = 8
DHB = 128
BAND_PREV = 8
REL_CLIP = 128
HR = 8
DKR = 64
DVR = 128
D_FF = 5632
CONV_W = 3
ROPE_THETA = 10000.0
ALPHA = (2 * DEPTH) ** 0.25
BETA = (8 * DEPTH) ** -0.25
EPS = 1e-5
SPLITS = (Q_LORA, KV_LORA, DR, HB * DHB, HB * DHB, HB * DHB,
          HR * DKR, HR * DKR, HR * DVR, HR * DVR, D_MODEL, D_MODEL, D_MODEL)
N_IN = sum(SPLITS)
SPLIT_POINTS = tuple(np.cumsum(SPLITS)[:-1].tolist())

kernel_name = 'hybrid_streaming_encoder_step'


def _layer_norm(x, g, b):
    xf = x.astype(jnp.float32)
    mu = jnp.mean(xf, -1, keepdims=True)
    var = jnp.mean(jnp.square(xf - mu), -1, keepdims=True)
    y = (xf - mu) * lax.rsqrt(var + EPS) * g.astype(jnp.float32) + b.astype(jnp.float32)
    return y.astype(x.dtype)


def _rms_norm(x, g):
    xf = x.astype(jnp.float32)
    y = xf * lax.rsqrt(jnp.mean(xf * xf, -1, keepdims=True) + EPS) * g.astype(jnp.float32)
    return y.astype(x.dtype)


def _rope(x, pos):
    half = x.shape[-1] // 2
    inv = ROPE_THETA ** (-jnp.arange(half, dtype=jnp.float32) / half)
    ang = pos.astype(jnp.float32)[:, None] * inv[None, :]
    shape = (1, x.shape[1]) + (1,) * (x.ndim - 3) + (half,)
    cos, sin = jnp.cos(ang).reshape(shape), jnp.sin(ang).reshape(shape)
    xf = x.astype(jnp.float32)
    x1, x2 = xf[..., :half], xf[..., half:]
    return jnp.concatenate([x1 * cos - x2 * sin, x2 * cos + x1 * sin], -1).astype(x.dtype)


def _mla_attend(q_nope, q_rope, k_nope, k_rope, v, q_pos, k_pos):
    s = (jnp.einsum('bqhd,bkhd->bhqk', q_nope, k_nope)
         + jnp.einsum('bqhr,bkr->bhqk', q_rope, k_rope)).astype(jnp.float32) * (DN + DR) ** -0.5
    allowed = (k_pos[None, :] // CHUNK) <= (q_pos[:, None] // CHUNK)
    s = jnp.where(allowed[None, None], s, -jnp.inf)
    p = jax.nn.softmax(s, axis=-1).astype(v.dtype)
    return jnp.einsum('bhqk,bkhe->bqhe', p, v)


def _mla_block_sweep(q_nope, q_rope, k_nope, k_rope, v, pos):
    B, T = q_nope.shape[:2]
    nb = T // Q_BLOCK

    def blk(a):
        qn, qr, qp = a
        return _mla_attend(qn, qr, k_nope, k_rope, v, qp, pos)

    o = lax.map(blk, (q_nope.reshape(B, nb, Q_BLOCK, HA, DN).swapaxes(0, 1),
                      q_rope.reshape(B, nb, Q_BLOCK, HA, DR).swapaxes(0, 1),
                      pos.reshape(nb, Q_BLOCK)))
    return o.swapaxes(0, 1).reshape(B, T, HA, DVA)


def _band_attend(q, k, v, q_pos, k_pos, rel_bias):
    s = jnp.einsum('bqhd,bkhd->bhqk', q, k).astype(jnp.float32) * DHB ** -0.5
    rel = jnp.clip(q_pos[:, None] - k_pos[None, :], -REL_CLIP, REL_CLIP) + REL_CLIP
    s = s + rel_bias[:, rel].astype(jnp.float32)[None]
    s = jnp.where((k_pos >= 0)[None, None, None, :], s, -jnp.inf)
    p = jax.nn.softmax(s, axis=-1).astype(v.dtype)
    return jnp.einsum('bhqk,bkhe->bqhe', p, v)


def _band_prompt(q, k, v, rel_bias):
    B, T = q.shape[:2]
    nc = T // CHUNK
    pad = BAND_PREV * CHUNK
    kp = jnp.pad(k, ((0, 0), (pad, 0), (0, 0), (0, 0)))
    vp = jnp.pad(v, ((0, 0), (pad, 0), (0, 0), (0, 0)))

    def one(a):
        qc, n = a
        start = n * CHUNK
        kb = lax.dynamic_slice_in_dim(kp, start, pad + CHUNK, axis=1)
        vb = lax.dynamic_slice_in_dim(vp, start, pad + CHUNK, axis=1)
        q_pos = start + jnp.arange(CHUNK, dtype=jnp.int32)
        k_pos = start - pad + jnp.arange(pad + CHUNK, dtype=jnp.int32)
        return _band_attend(qc, kb, vb, q_pos, k_pos, rel_bias)

    o = lax.map(one, (q.reshape(B, nc, CHUNK, HB, DHB).swapaxes(0, 1),
                      jnp.arange(nc, dtype=jnp.int32)))
    return o.swapaxes(0, 1).reshape(B, T, HB, DHB)


def _ret_log_decay():
    return jnp.log1p(-jnp.exp2(-5.0 - jnp.arange(HR, dtype=jnp.float32)))


def _ret_chunk(S, q, k, v, lg):
    L = q.shape[1]
    idx = jnp.arange(L, dtype=jnp.float32)
    diff = idx[:, None] - idx[None, :]
    dmask = jnp.where(diff[None] >= 0, jnp.exp(jnp.maximum(diff, 0.0)[None] * lg[:, None, None]), 0.0)
    inner = jnp.einsum('bnhd,bmhd->bhnm', q, k) * dmask[None]
    o = jnp.einsum('bhnm,bmhe->bnhe', inner, v)
    q_dec = q * jnp.exp((idx[:, None] + 1.0) * lg[None, :])[None, :, :, None]
    o = o + jnp.einsum('bnhd,bhde->bnhe', q_dec, S)
    k_dec = k * jnp.exp((L - 1.0 - idx)[:, None] * lg[None, :])[None, :, :, None]
    S_new = jnp.exp(L * lg)[None, :, None, None] * S + jnp.einsum('bmhd,bmhe->bhde', k_dec, v)
    return S_new, o


def _ret_prompt(q, k, v, lg):
    B, T = q.shape[:2]
    nc = T // CHUNK

    def to_c(a):
        return a.reshape(B, nc, CHUNK, HR, a.shape[-1]).swapaxes(0, 1)

    S0 = jnp.zeros((B, HR, DKR, DVR), jnp.float32)
    S, o = lax.scan(lambda S, a: _ret_chunk(S, a[0], a[1], a[2], lg), S0, (to_c(q), to_c(k), to_c(v)))
    return S, o.swapaxes(0, 1).reshape(B, T, HR, DVR)


def _head_norm(o, g):
    B, T = o.shape[:2]
    mu = jnp.mean(o, -1, keepdims=True)
    var = jnp.mean(jnp.square(o - mu), -1, keepdims=True)
    return ((o - mu) * lax.rsqrt(var + EPS)).reshape(B, T, HR * DVR) * g.astype(jnp.float32)


def _conv_ffn(h, prev, w_a, w_b, cw, cb, w_down):
    T = h.shape[1]
    a = h @ w_a
    b = h @ w_b
    ap = jnp.concatenate([prev.astype(a.dtype), a], axis=1)
    conv = cb + ap[:, 0:T] * cw[0] + ap[:, 1:T + 1] * cw[1] + ap[:, 2:T + 2] * cw[2]
    y = (jax.nn.gelu(conv, approximate=False) * b) @ w_down
    return y, ap[:, T:]


def _layer(x, c, pos, cache, prm):
    (w_ada, b_ada, w_in, g_q, g_kv, w_uq, w_ukv, rel_bias, g_rn, w_pa, w_pb, w_pc,
     w_o, ln1_g, ln1_b, w_fa, w_fb, cw, cb, w_fd, ln2_g, ln2_b) = prm
    B, T, _ = x.shape
    ada = jax.nn.silu(c) @ w_ada + b_ada
    sh1, sc1, gt1, sh2, sc2, gt2 = [a[:, None, :] for a in jnp.split(ada, 6, axis=-1)]
    h = x * (1.0 + sc1) + sh1
    (cq, ckv_raw, kr_raw, qb, kb, vb, qr, kr, vr, gr, g_a, g_b, g_c) = jnp.split(h @ w_in, SPLIT_POINTS, axis=-1)

    qa = (_rms_norm(cq, g_q) @ w_uq).reshape(B, T, HA, DN + DR)
    q_nope, q_rope = qa[..., :DN], _rope(qa[..., DN:], pos)
    ckv = _rms_norm(ckv_raw, g_kv)
    krope = _rope(kr_raw, pos)
    if cache is None:
        ckv_all, kr_all, k_pos = ckv, krope, pos
    else:
        ckv_all = jnp.concatenate([cache[0].astype(ckv.dtype), ckv], axis=1)
        kr_all = jnp.concatenate([cache[1].astype(krope.dtype), krope], axis=1)
        k_pos = jnp.arange(ckv_all.shape[1], dtype=jnp.int32)
    kv = (ckv_all @ w_ukv).reshape(B, ckv_all.shape[1], HA, DN + DVA)
    k_nope, va = kv[..., :DN], kv[..., DN:]
    if cache is None:
        oa = _mla_block_sweep(q_nope, q_rope, k_nope, kr_all, va, pos)
    else:
        oa = _mla_attend(q_nope, q_rope, k_nope, kr_all, va, pos, k_pos)
    oa = oa.reshape(B, T, HA * DVA)

    qb = qb.reshape(B, T, HB, DHB)
    kb = kb.reshape(B, T, HB, DHB)
    vb = vb.reshape(B, T, HB, DHB)
    if cache is None:
        ob = _band_prompt(qb, kb, vb, rel_bias)
        keep = min(BAND_PREV * CHUNK, T)
        bk_new, bv_new = kb[:, T - keep:], vb[:, T - keep:]
    else:
        kc = cache[2].astype(kb.dtype)
        vc = cache[3].astype(vb.dtype)
        nk = kc.shape[1]
        kb_pos = pos[0] - nk + jnp.arange(nk + T, dtype=jnp.int32)
        ob = _band_attend(qb, jnp.concatenate([kc, kb], 1), jnp.concatenate([vc, vb], 1), pos, kb_pos, rel_bias)
        bk_new, bv_new = kb, vb
    ob = ob.reshape(B, T, HB * DHB)

    lg = _ret_log_decay()
    q_r = _rope(qr.reshape(B, T, HR, DKR), pos).astype(jnp.float32) * DKR ** -0.5
    k_r = _rope(kr.reshape(B, T, HR, DKR), pos).astype(jnp.float32)
    v_r = vr.reshape(B, T, HR, DVR).astype(jnp.float32)
    if cache is None:
        S_new, o_r = _ret_prompt(q_r, k_r, v_r, lg)
    else:
        S_new, o_r = _ret_chunk(cache[4].astype(jnp.float32), q_r, k_r, v_r, lg)
    oc = (jax.nn.silu(gr.astype(jnp.float32)) * _head_norm(o_r, g_rn)).astype(x.dtype)

    merged = (jax.nn.sigmoid(g_a) * (oa @ w_pa) + jax.nn.sigmoid(g_b) * (ob @ w_pb)
              + jax.nn.sigmoid(g_c) * (oc @ w_pc))
    x = _layer_norm(ALPHA * x + (1.0 + gt1) * (merged @ w_o), ln1_g, ln1_b)

    h2 = x * (1.0 + sc2) + sh2
    prev = jnp.zeros((B, CONV_W - 1, D_FF), x.dtype) if cache is None else cache[5]
    y, conv_new = _conv_ffn(h2, prev, w_fa, w_fb, cw, cb, w_fd)
    x = _layer_norm(ALPHA * x + (1.0 + gt2) * y, ln2_g, ln2_b)
    return x, (ckv, krope, bk_new, bv_new, S_new, conv_new)


def setup_inputs(seed: int = 0) -> dict:
    key = jax.random.key(seed)
    ks = iter(jax.random.split(key, 48))
    f32 = jnp.float32

    def nrm(shape, scale):
        return jax.random.normal(next(ks), shape, f32) * scale

    band_cache = min(BAND_PREV * CHUNK, PAST_LEN)
    L = DEPTH
    return {
        'x_prompt': nrm((BATCH, SEQ, D_MODEL), 1.0),
        'x_sample': nrm((DEC_BATCH, DEC_SEQ, D_MODEL), 1.0),
        'c_prompt': nrm((BATCH, D_MODEL), 1.0),
        'c_sample': nrm((DEC_BATCH, D_MODEL), 1.0),
        'cache_mla_ckv': nrm((L, DEC_BATCH, PAST_LEN, KV_LORA), 1.0),
        'cache_mla_krope': nrm((L, DEC_BATCH, PAST_LEN, DR), 1.0),
        'cache_band_k': nrm((L, DEC_BATCH, band_cache, HB, DHB), 1.0),
        'cache_band_v': nrm((L, DEC_BATCH, band_cache, HB, DHB), 1.0),
        'state_ret': nrm((L, DEC_BATCH, HR, DKR, DVR), 1.0),
        'state_conv': nrm((L, DEC_BATCH, CONV_W - 1, D_FF), 1.0),
        'w_ada': nrm((L, D_MODEL, 6 * D_MODEL), 0.1 * D_MODEL ** -0.5),
        'b_ada': nrm((L, 6 * D_MODEL), 0.01),
        'w_in': nrm((L, D_MODEL, N_IN), D_MODEL ** -0.5),
        'g_q_lora': 1.0 + nrm((L, Q_LORA), 0.1),
        'g_kv_lora': 1.0 + nrm((L, KV_LORA), 0.1),
        'w_uq': nrm((L, Q_LORA, HA * (DN + DR)), Q_LORA ** -0.5),
        'w_ukv': nrm((L, KV_LORA, HA * (DN + DVA)), KV_LORA ** -0.5),
        'rel_bias': nrm((L, HB, 2 * REL_CLIP + 1), 0.2),
        'g_ret_norm': 1.0 + nrm((L, HR * DVR), 0.1),
        'w_branch_a': nrm((L, HA * DVA, D_MODEL), (HA * DVA) ** -0.5),
        'w_branch_b': nrm((L, HB * DHB, D_MODEL), (HB * DHB) ** -0.5),
        'w_branch_c': nrm((L, HR * DVR, D_MODEL), (HR * DVR) ** -0.5),
        'w_o': nrm((L, D_MODEL, D_MODEL), BETA * D_MODEL ** -0.5),
        'ln1_g': 1.0 + nrm((L, D_MODEL), 0.1),
        'ln1_b': nrm((L, D_MODEL), 0.02),
        'w_ff_a': nrm((L, D_MODEL, D_FF), D_MODEL ** -0.5),
        'w_ff_b': nrm((L, D_MODEL, D_FF), D_MODEL ** -0.5),
        'conv_w': nrm((L, CONV_W, D_FF), CONV_W ** -0.5),
        'conv_b': nrm((L, D_FF), 0.02),
        'w_ff_down': nrm((L, D_FF, D_MODEL), BETA * D_FF ** -0.5),
        'ln2_g': 1.0 + nrm((L, D_MODEL), 0.1),
        'ln2_b': nrm((L, D_MODEL), 0.02),
    }


def reference(x_prompt, x_sample, c_prompt, c_sample, cache_mla_ckv, cache_mla_krope,
              cache_band_k, cache_band_v, state_ret, state_conv, w_ada, b_ada, w_in,
              g_q_lora, g_kv_lora, w_uq, w_ukv, rel_bias, g_ret_norm, w_branch_a,
              w_branch_b, w_branch_c, w_o, ln1_g, ln1_b, w_ff_a, w_ff_b, conv_w, conv_b,
              w_ff_down, ln2_g, ln2_b):
    past = cache_mla_ckv.shape[2]
    pos_p = jnp.arange(x_prompt.shape[1], dtype=jnp.int32)
    pos_s = past + jnp.arange(x_sample.shape[1], dtype=jnp.int32)
    y_prompt, y_sample = x_prompt, x_sample
    new_p, new_s = [], []
    for l in range(DEPTH):
        prm = (w_ada[l], b_ada[l], w_in[l], g_q_lora[l], g_kv_lora[l], w_uq[l], w_ukv[l],
               rel_bias[l], g_ret_norm[l], w_branch_a[l], w_branch_b[l], w_branch_c[l],
               w_o[l], ln1_g[l], ln1_b[l], w_ff_a[l], w_ff_b[l], conv_w[l], conv_b[l],
               w_ff_down[l], ln2_g[l], ln2_b[l])
        y_prompt, st_p = _layer(y_prompt, c_prompt, pos_p, None, prm)
        cache_l = (cache_mla_ckv[l], cache_mla_krope[l], cache_band_k[l], cache_band_v[l],
                   state_ret[l], state_conv[l])
        y_sample, st_s = _layer(y_sample, c_sample, pos_s, cache_l, prm)
        new_p.append(st_p)
        new_s.append(st_s)
    mla_ckv_p, mla_kr_p, band_k_p, band_v_p, ret_p, conv_p = [jnp.stack(z) for z in zip(*new_p)]
    mla_ckv_s, mla_kr_s, band_k_s, band_v_s, ret_s, conv_s = [jnp.stack(z) for z in zip(*new_s)]
    return (y_prompt, y_sample, mla_ckv_p, mla_kr_p, band_k_p, band_v_p, ret_p, conv_p,
            mla_ckv_s, mla_kr_s, band_k_s, band_v_s, ret_s, conv_s)
```

```cpp
#include <hip/hip_runtime.h>
#include <cstdio>
#include <cstdint>

#ifndef MK_ONE_LAUNCH
#define MK_ONE_LAUNCH 1
#endif

#define LAS __attribute__((address_space(3)))
typedef unsigned short bf16_t;
typedef short bf16x8 __attribute__((ext_vector_type(8)));
typedef float f32x4 __attribute__((ext_vector_type(4)));
typedef float f32x2 __attribute__((ext_vector_type(2)));
typedef float f32x16 __attribute__((ext_vector_type(16)));
typedef unsigned u32x4 __attribute__((ext_vector_type(4)));
typedef unsigned u32x2 __attribute__((ext_vector_type(2)));

constexpr int DM = 2048, NB = 4, TT = 8192, MP = NB * TT, SB = 32, ST = 16, MS = SB * ST, MX = MP + MS;
constexpr int PAST = 1024, KVS = PAST + ST, KVROWS = MP + SB * KVS;
constexpr int NSTREAM = NB + SB, NADA = 6 * DM;
constexpr int NIN_SRC = 13120, NPROJ_ALL = 13312, NPROJ = 7168, DFF = 5632, NFAB = 2 * DFF;
constexpr int NG = 2;
constexpr int GPR = MP / NG, GXR = GPR + MS, GKV = GPR + SB * KVS, VT_LD = GKV + 64;
constexpr int GNB = NB / NG;
constexpr int PC_CQ = 0, PC_CKV = 512, PC_KR = 768, PC_QB = 1024, PC_KB = 2048, PC_VB = 3072, PC_QR = 4096, PC_KRR = 4608, PC_VR = 5120, PC_GR = 6144, PC_GA = 7168;
constexpr float LOG2E = 1.4426950408889634f;
constexpr float C_A = 0.10411754627697264f;
constexpr float C_B = 0.12751743082459868f;
constexpr float ALPHA = 1.4142135623730951f;
constexpr float EPS = 1e-5f;

constexpr size_t O_Y = 0, O_CKV_P = 68157440, O_KR_P = 84934656, O_BK_P = 89128960, O_BV_P = 93323264, O_RET_P = 97517568, O_CONV_P = 98041856,
                 O_CKV_S = 98131968, O_KR_S = 98394112, O_BK_S = 98459648, O_BV_S = 99508224, O_RET_S = 100556800, O_CONV_S = 104751104;

constexpr size_t al256(size_t x) { return (x + 255) & ~(size_t)255; }
constexpr size_t WS_CTL = 0, WS_CTL_BYTES = 65536;
constexpr size_t WS_ADA = WS_CTL + WS_CTL_BYTES;
constexpr size_t WS_ROPE = WS_ADA + al256((size_t)2 * NSTREAM * NADA * 4);
constexpr size_t WS_SQ = WS_ROPE + (size_t)TT * 32 * 8;
constexpr size_t WS_WT = WS_SQ + al256((size_t)MX * 4);
constexpr size_t WT_IN = 0, WT_UQ = WT_IN + (size_t)NPROJ_ALL * 2048, WT_UK = WT_UQ + (size_t)1536 * 512, WT_UV = WT_UK + (size_t)1024 * 256, WT_P = WT_UV + (size_t)1024 * 256,
                 WT_O = WT_P + (size_t)2048 * 3072, WT_FAB = WT_O + (size_t)2048 * 2048, WT_FD = WT_FAB + (size_t)NFAB * 2048, WT_END = WT_FD + (size_t)2048 * DFF;
constexpr size_t WS_H = WS_WT + al256(WT_END * 2);
constexpr size_t WS_XB = WS_H + (size_t)MX * DM * 2;
constexpr size_t WS_BIG = WS_XB + (size_t)MX * DM * 2;
constexpr size_t WB_PROJ = WS_BIG;
constexpr size_t WB_GATE = WB_PROJ + (size_t)GXR * NPROJ * 2;
constexpr size_t WB_Q = WB_GATE + (size_t)3 * (GXR / 256) * 8 * 65536 * 2;
constexpr size_t WB_CKV = WB_Q + (size_t)GXR * 1536 * 2;
constexpr size_t WB_KROPE = WB_CKV + (size_t)GKV * 256 * 2;
constexpr size_t WB_KNOPE = WB_KROPE + (size_t)(GKV + 64) * 64 * 2;
constexpr size_t WB_VT = WB_KNOPE + (size_t)(GKV + 64) * 1024 * 2;
constexpr size_t WB_OCAT = WB_VT + (size_t)1024 * VT_LD * 2;
constexpr size_t WB_MERGED = WB_KNOPE;
constexpr size_t WB_RETS = WB_OCAT + (size_t)GXR * 3072 * 2;
constexpr size_t WB_RETB = WB_RETS + (size_t)GNB * 8 * 128 * 8192 * 2;
constexpr size_t WB_END = WB_RETB + (size_t)GNB * 8 * 128 * 8192 * 2;
constexpr size_t WF_U = WS_BIG;
constexpr size_t WF_SIDE = WF_U + (size_t)MX * DFF * 2;
constexpr size_t WF_END = WF_SIDE + (size_t)(MX / 16) * 6 * DFF * 2;
constexpr size_t WS_END = (WB_END > WF_END ? WB_END : WF_END);

#define XB_TMO      128
#define XB_XCNT(j)  (256  + 64 * (j))
#define XB_XSUB(j)  (1280 + 64 * (j))
#define XB_XGEN(j)  (2304 + 64 * (j))
#define XB_TOP      3328
#define XB_TOPGEN   3392
#define XCD_BAR_WORDS 3456
#define XB_SPIN_CAP (1u << 22)
__device__ __forceinline__ unsigned xb_ld(unsigned* p)              { return __hip_atomic_load(p, __ATOMIC_RELAXED, __HIP_MEMORY_SCOPE_AGENT); }
__device__ __forceinline__ unsigned xb_add(unsigned* p, unsigned v) { return __hip_atomic_fetch_add(p, v, __ATOMIC_RELAXED, __HIP_MEMORY_SCOPE_AGENT); }
__device__ __forceinline__ unsigned xb_xcc_id() { return (unsigned)__builtin_amdgcn_s_getreg((3 << 11) | 20) & 0xFu; }
#define XB_SPIN(cond, bar) do { unsigned _sp = 0; while (cond) { __builtin_amdgcn_s_sleep(1); \
    if ((++_sp & 255u) == 0u) { if (xb_ld(&(bar)[XB_TMO])) break; if (_sp > XB_SPIN_CAP) { atomicAdd(&(bar)[XB_TMO], 1u); break; } } } } while (0)
struct XcdBarrier { unsigned* bar; unsigned x; volatile LAS unsigned* st; };
__device__ __forceinline__ XcdBarrier xcd_barrier_post(unsigned* bar, volatile LAS unsigned* st) {
    XcdBarrier b; b.bar = bar; b.x = xb_xcc_id(); b.st = st;
    if (threadIdx.x == 0) (void)xb_add(&bar[XB_XCNT(b.x)], 1u);
    return b;
}
__device__ __forceinline__ void xcd_barrier_complete(unsigned* bar, unsigned x, unsigned& nloc, unsigned& nx) {
    const unsigned G = gridDim.x * gridDim.y * gridDim.z;
    unsigned sum, cnt, mine, sp = 0u;
    for (;;) {
        sum = 0u; cnt = 0u; mine = 0u;
#pragma unroll
        for (unsigned j = 0; j < 16; ++j) { const unsigned c = xb_ld(&bar[XB_XCNT(j)]); sum += c; cnt += (c > 0u) ? 1u : 0u; mine = (j == x) ? c : mine; }
        if (sum == G) break;
        __builtin_amdgcn_s_sleep(1);
        if ((++sp & 255u) == 0u) { if (xb_ld(&bar[XB_TMO])) break; if (sp > XB_SPIN_CAP) { atomicAdd(&bar[XB_TMO], 1u); break; } }
    }
    nloc = mine > 0u ? mine : 1u; nx = cnt > 0u ? cnt : 1u;
}
__device__ __forceinline__ void xcd_barrier(const XcdBarrier& b, const int tid0) {
    asm volatile("s_waitcnt vmcnt(0)" ::: "memory");
    __syncthreads();
    if (tid0 == 0) {
        unsigned* bar = b.bar;
        __builtin_amdgcn_s_waitcnt(0);
        unsigned nloc = b.st[0], nx = b.st[1];
        if (nloc == 0u) { xcd_barrier_complete(bar, b.x, nloc, nx); b.st[0] = nloc; b.st[1] = nx; }
        const unsigned old = xb_add(&bar[XB_XSUB(b.x)], 1u);
        const unsigned gen = old / nloc;
        if (old + 1u == (gen + 1u) * nloc) {
            __builtin_amdgcn_fence(__ATOMIC_RELEASE, "agent");
            asm volatile("s_waitcnt vmcnt(0)" ::: "memory");
            const unsigned og = xb_add(&bar[XB_TOP], 1u);
            const unsigned tg = og / nx;
            if (og + 1u == (tg + 1u) * nx) xb_add(&bar[XB_TOPGEN], 1u);
            else XB_SPIN(xb_ld(&bar[XB_TOPGEN]) == tg, bar);
            __builtin_amdgcn_fence(__ATOMIC_ACQUIRE, "agent");
            xb_add(&bar[XB_XGEN(b.x)], 1u);
            asm volatile("s_waitcnt vmcnt(0)" ::: "memory");
        } else {
            XB_SPIN(xb_ld(&bar[XB_XGEN(b.x)]) == gen, bar);
            __builtin_amdgcn_fence(__ATOMIC_ACQUIRE, "agent");
            asm volatile("s_waitcnt vmcnt(0)" ::: "memory");
        }
    }
    __syncthreads();
}

__device__ __forceinline__ unsigned cvt_pk_bf16(float lo, float hi) { unsigned r; asm volatile("v_cvt_pk_bf16_f32 %0, %1, %2" : "=v"(r) : "v"(lo), "v"(hi)); return r; }
__device__ __forceinline__ float bf_lo(unsigned w) { return __uint_as_float(w << 16); }
__device__ __forceinline__ float bf_hi(unsigned w) { return __uint_as_float(w & 0xffff0000u); }
__device__ __forceinline__ float wave_sum(float v) {
    v += __int_as_float(__builtin_amdgcn_ds_swizzle(__float_as_int(v), 0x041F));
    v += __int_as_float(__builtin_amdgcn_ds_swizzle(__float_as_int(v), 0x081F));
    v += __int_as_float(__builtin_amdgcn_ds_swizzle(__float_as_int(v), 0x101F));
    v += __int_as_float(__builtin_amdgcn_ds_swizzle(__float_as_int(v), 0x201F));
    v += __int_as_float(__builtin_amdgcn_ds_swizzle(__float_as_int(v), 0x401F));
    auto rr = __builtin_amdgcn_permlane32_swap(__float_as_uint(v), __float_as_uint(v), false, false);
    return __uint_as_float(rr[0]) + __uint_as_float(rr[1]);
}
__device__ __forceinline__ int opaque_tid(int wave_s) { int t; asm volatile("v_mbcnt_lo_u32_b32 %0, -1, 0\n\tv_mbcnt_hi_u32_b32 %0, -1, %0" : "=v"(t)); return (wave_s << 6) | t; }
__device__ __forceinline__ int lane_id_v() { int t; asm volatile("v_mbcnt_lo_u32_b32 %0, -1, 0\n\tv_mbcnt_hi_u32_b32 %0, -1, %0" : "=v"(t)); return t; }
__device__ __forceinline__ float fast_rcp(float x) { return __builtin_amdgcn_rcpf(x); }
__device__ __forceinline__ float sigmoidf_(float x) { return fast_rcp(1.0f + __builtin_amdgcn_exp2f(-x * LOG2E)); }
__device__ __forceinline__ int row_stream(int ar) { return ar < MP ? (ar >> 13) : NB + ((ar - MP) >> 4); }
__device__ __forceinline__ int row_pos(int ar) { return ar < MP ? (ar & (TT - 1)) : PAST + ((ar - MP) & 15); }
__device__ __forceinline__ int row_kv(int ar) { return ar < MP ? ar : MP + ((ar - MP) >> 4) * KVS + PAST + ((ar - MP) & 15); }
__device__ __forceinline__ float lg2_gamma(int h) {
    return h == 0 ? -0.04580368961312479f : h == 1 ? -0.02272007650008353f : h == 2 ? -0.011315313227834146f : h == 3 ? -0.005646563141142063f :
           h == 4 ? -0.0028205190623786626f : h == 5 ? -0.0014095702546713536f : h == 6 ? -0.0007046129765893727f : -0.0003522634716290214f;
}
__device__ __forceinline__ float gelu1(float v) {
    const float av = fabsf(v), d = av * 0.2316418882f + 1.0f;
    const float t = __builtin_amdgcn_rcpf(d);
    float q = t * 0.5307027145f + (-0.7265760135f); q = q * t + 0.7107068705f; q = q * t + (-0.142248368f); q = q * t + 0.127414796f; q = q * t;
    const float e = __builtin_amdgcn_exp2f((v * v) * (-0.72134752044f));
    const float m = v * (q * e), r = v - m;
    return v < 0.f ? m : r;
}

struct Params {
    const float* in[32];
    float* out;
    unsigned char* ws;
    int ph_lo, ph_hi;
};
struct PT { LAS unsigned long long* t;
    __device__ __forceinline__ const float* in(int k) const { const unsigned long long v = t[k]; const unsigned lo = __builtin_amdgcn_readfirstlane((unsigned)v), hi = __builtin_amdgcn_readfirstlane((unsigned)(v >> 32)); return (const float*)(const __attribute__((address_space(1))) float*)(((unsigned long long)hi << 32) | lo); }
};

namespace pg8 {
constexpr int BM = 256, BK = 64, HALF = 128, HTB = HALF * BK * 2, STAGE_BYTES = 8 * HTB, NXCD = 8, WGM = 4;
__host__ __device__ __forceinline__ int lds_byte(int r, int c) { const int st = (r >> 4) * 2 + (c >> 5), rr = r & 15, cc = c & 31, ob = rr * 64 + cc * 2; return st * 1024 + (ob ^ (((ob >> 9) & 1) << 5)); }
__host__ __device__ __forceinline__ void stage_rc(int b, int& R, int& C) { const int st = b / 1024, sb = b % 1024, swz = sb ^ (((sb >> 9) & 1) << 5); R = (st >> 1) * 16 + swz / 64; C = (st & 1) * 32 + (swz % 64) / 2; }
__host__ __device__ __forceinline__ int perm32(int rho) { const int n = rho >> 4, i = rho & 15; return 8 * (i >> 2) + 4 * n + (i & 3); }
struct Unit { int pm, pn; };
struct Gemm { const bf16_t* A; const bf16_t* Bt; int M, N, K, lda, ldb; };
struct StaticOrder {
    int nM, nN, nwg, G, c;
    __host__ __device__ void init(int M, int N, int G_, int c_) { nM = M / BM; nN = N / BM; nwg = nM * nN; G = G_; c = c_; }
    __host__ __device__ bool next(int i, Unit& u) const {
        const long L = (long)i * G + c; if (L >= nwg) return false;
        int wgid = (int)L; { const int q = nwg / NXCD, r = nwg % NXCD, xcd = wgid % NXCD, off = wgid / NXCD; wgid = (xcd < r ? xcd * (q + 1) : r * (q + 1) + (xcd - r) * q) + off; }
        const int nig = WGM * nN, gid = wgid / nig, fm = gid * WGM, gsz = (nM - fm) < WGM ? (nM - fm) : WGM;
        u.pm = fm + ((wgid % nig) % gsz); u.pn = (wgid % nig) / gsz; return true;
    }
};

template <class Epi>
__device__ __forceinline__ void gemm_phase(const int tid, LAS unsigned char* lds, const Gemm g, const StaticOrder& S, const Epi& E) {
    const int wid = __builtin_amdgcn_readfirstlane(tid >> 6), lane = tid & 63, wr = wid >> 2, wc = wid & 3, fr = lane & 15, fq = lane >> 4;
    const int K = g.K, nt = K / BK;
    unsigned voffA[2], voffB[2];
#pragma unroll
    for (int i = 0; i < 2; ++i) { int R, C; stage_rc(tid * 16 + i * 8192, R, C); const int Rb = Epi::PERM ? ((R & ~31) + perm32(R & 31)) : R;
        voffA[i] = (unsigned)(R * g.lda + C) * 2u; voffB[i] = (unsigned)(Rb * g.ldb + C) * 2u; }
    const size_t kstep = (size_t)(BK * 2);
    const size_t hstepA = (size_t)HALF * g.lda * 2, hstepB = (size_t)HALF * g.ldb * 2;
    const size_t tstepA = 2 * hstepA, tstepB = 2 * hstepB;
    const unsigned ldsw = (unsigned)wid * 1024u;
    const int aoff = lds_byte(wr * 64 + fr, fq * 8), boff = lds_byte(wc * 32 + fr, fq * 8);
#define PG8_SA(b, h) (((b) * 2 + (h)) * HTB)
#define PG8_SB(b, h) ((4 + (b) * 2 + (h)) * HTB)
#define PG8_STAGE(bufoff, gbase, voff) do { _Pragma("unroll") for (int _i = 0; _i < 2; ++_i) \
        __builtin_amdgcn_global_load_lds((const unsigned*)((const char*)(gbase) + (voff)[_i]), (LAS unsigned*)(lds + (bufoff) + ldsw + _i * 8192), 16, 0, 0); } while (0)
#define PG8_LDA(dst, b, h) do { _Pragma("unroll") for (int m = 0; m < 4; ++m) _Pragma("unroll") for (int k = 0; k < 2; ++k) dst[m][k] = *(const LAS bf16x8*)(lds + PG8_SA(b, h) + aoff + m * 2048 + k * 1024); } while (0)
#define PG8_LDB(dst, b, h) do { _Pragma("unroll") for (int n = 0; n < 2; ++n) _Pragma("unroll") for (int k = 0; k < 2; ++k) dst[n][k] = *(const LAS bf16x8*)(lds + PG8_SB(b, h) + boff + n * 2048 + k * 1024); } while (0)
#define PG8_MMA(ai, bj, At, Bt) do { __builtin_amdgcn_s_setprio(1); _Pragma("unroll") for (int m = 0; m < 4; ++m) _Pragma("unroll") for (int n = 0; n < 2; ++n) _Pragma("unroll") for (int k = 0; k < 2; ++k) \
        acc[ai][bj][m][n] = __builtin_amdgcn_mfma_f32_16x16x32_bf16(Bt[n][k], At[m][k], acc[ai][bj][m][n], 0, 0, 0); __builtin_amdgcn_s_setprio(0); } while (0)
#define PG8_WAIT_V(n) asm volatile("s_waitcnt vmcnt(" #n ")" ::: "memory")
#define PG8_WAIT_L(n) asm volatile("s_waitcnt lgkmcnt(" #n ")" ::: "memory")
#define PG8_BAR __builtin_amdgcn_s_barrier()
#define PG8_SCHED __builtin_amdgcn_sched_barrier(0)
    Unit cur, nxt; int ui = 0;
    if (!S.next(0, cur)) return;
    f32x4 acc[2][2][4][2];
#pragma unroll
    for (int a = 0; a < 2; ++a)
#pragma unroll
        for (int b = 0; b < 2; ++b)
#pragma unroll
            for (int m = 0; m < 4; ++m)
#pragma unroll
                for (int n = 0; n < 2; ++n) acc[a][b][m][n] = (f32x4){0.f, 0.f, 0.f, 0.f};
    bf16x8 At[4][2], B0[2][2], B1[2][2];
    const char* cA = (const char*)g.A + (size_t)cur.pm * tstepA; const char* cB = (const char*)g.Bt + (size_t)cur.pn * tstepB;
    PG8_STAGE(PG8_SB(0, 0), cB, voffB); PG8_STAGE(PG8_SB(0, 1), cB + hstepB, voffB); PG8_STAGE(PG8_SA(0, 0), cA, voffA); PG8_STAGE(PG8_SA(0, 1), cA + hstepA, voffA);
    if (wr == 1) PG8_BAR;
    PG8_WAIT_V(2); PG8_BAR;
    PG8_STAGE(PG8_SB(1, 0), cB + kstep, voffB); PG8_STAGE(PG8_SA(1, 0), cA + kstep, voffA); PG8_STAGE(PG8_SB(1, 1), cB + hstepB + kstep, voffB);
    PG8_WAIT_V(6); PG8_BAR;
    for (;;) {
        const bool has_next = S.next(ui + 1, nxt);
        const char* nA = has_next ? (const char*)g.A + (size_t)nxt.pm * tstepA : cA; const char* nB = has_next ? (const char*)g.Bt + (size_t)nxt.pn * tstepB : cB;
        for (int t = 0; t < nt; t += 2) {
            const bool last = (t == nt - 2);
            const char* a1 = cA + (size_t)(t + 1) * kstep;
            const char* a2 = last ? nA : cA + (size_t)(t + 2) * kstep; const char* b2 = last ? nB : cB + (size_t)(t + 2) * kstep;
            const char* a3 = a2 + kstep; const char* b3 = b2 + kstep;
            if constexpr (Epi::HOOK) { if (t == 16 || t == 32) { PG8_SCHED; E.hook(acc, cur, t == 16 ? 0 : 1, wr, wc, fr, fq); PG8_SCHED; } }
            PG8_LDB(B0, 0, 0); PG8_LDB(B1, 0, 1); PG8_SCHED; PG8_LDA(At, 0, 0); PG8_STAGE(PG8_SA(1, 1), a1 + hstepA, voffA);
            PG8_WAIT_V(8); PG8_WAIT_L(0); PG8_BAR; PG8_MMA(0, 0, At, B0); PG8_MMA(0, 1, At, B1); PG8_BAR; PG8_SCHED;
            PG8_LDA(At, 0, 1); PG8_STAGE(PG8_SB(0, 0), b2, voffB); PG8_STAGE(PG8_SB(0, 1), b2 + hstepB, voffB); PG8_STAGE(PG8_SA(0, 0), a2, voffA);
            PG8_WAIT_V(8); PG8_WAIT_L(0); PG8_BAR; PG8_MMA(1, 0, At, B0); PG8_MMA(1, 1, At, B1); PG8_BAR; PG8_SCHED;
            PG8_LDB(B0, 1, 0); PG8_LDB(B1, 1, 1); PG8_SCHED; PG8_LDA(At, 1, 0); PG8_STAGE(PG8_SA(0, 1), a2 + hstepA, voffA);
            PG8_WAIT_V(8); PG8_WAIT_L(0); PG8_BAR; PG8_MMA(0, 0, At, B0); PG8_MMA(0, 1, At, B1); PG8_BAR; PG8_SCHED;
            PG8_LDA(At, 1, 1); PG8_STAGE(PG8_SB(1, 0), b3, voffB); PG8_STAGE(PG8_SB(1, 1), b3 + hstepB, voffB); PG8_STAGE(PG8_SA(1, 0), a3, voffA);
            PG8_WAIT_V(8); PG8_WAIT_L(0); PG8_BAR; PG8_MMA(1, 0, At, B0); PG8_MMA(1, 1, At, B1); PG8_BAR; PG8_SCHED;
        }
        if (wr == 0) PG8_BAR;
        E(acc, cur, wr, wc, fr, fq);
        if (!has_next) break;
#pragma unroll
        for (int a = 0; a < 2; ++a)
#pragma unroll
            for (int b = 0; b < 2; ++b)
#pragma unroll
                for (int m = 0; m < 4; ++m)
#pragma unroll
                    for (int n = 0; n < 2; ++n) acc[a][b][m][n] = (f32x4){0.f, 0.f, 0.f, 0.f};
        cur = nxt; cA = nA; cB = nB; ++ui;
        if (wr == 1) PG8_BAR;
    }
    PG8_WAIT_V(0);
    PG8_BAR;
#undef PG8_SA
#undef PG8_SB
#undef PG8_STAGE
#undef PG8_LDA
#undef PG8_LDB
#undef PG8_MMA
#undef PG8_WAIT_V
#undef PG8_WAIT_L
#undef PG8_BAR
#undef PG8_SCHED
}
}
using pg8::Unit;

struct EpiProj {
    static constexpr bool PERM = true, HOOK = false;
    bf16_t* O; bf16_t* GB;
    __device__ __forceinline__ void operator()(const f32x4 (&acc)[2][2][4][2], const Unit& u, int wr, int wc, int, int) const {
        const int ln_ = lane_id_v(); const int fr = ln_ & 15, fq = ln_ >> 4;
        const int pn = u.pn; const int mode = (pn >= 28) ? 2 : (pn >= 24 ? 1 : ((pn >= 4 && pn < 8) ? 3 : 0));
        bf16_t* base; int ld;
        if (mode == 2) { const int br = (pn - 28) >> 3, pnl = (pn - 28) & 7; base = GB + (((size_t)br * (GXR / 256) + u.pm) * 8 + pnl) * 65536 + (size_t)(wr * 64 + fr) * 256 + wc * 32 + 8 * fq; ld = 256; }
        else { base = O + (size_t)(u.pm * 256 + wr * 64 + fr) * NPROJ + u.pn * 256 + wc * 32 + 8 * fq; ld = NPROJ; }
#pragma unroll
        for (int ai = 0; ai < 2; ++ai)
#pragma unroll
            for (int m = 0; m < 4; ++m) { bf16_t* rowp = base + (size_t)(ai * 128 + m * 16) * ld;
#pragma unroll
                for (int bj = 0; bj < 2; ++bj) { f32x4 v0 = acc[ai][bj][m][0], v1 = acc[ai][bj][m][1];
                    if (mode == 2) {
#pragma unroll
                        for (int j = 0; j < 4; ++j) { v0[j] = sigmoidf_(v0[j]); v1[j] = sigmoidf_(v1[j]); } }
                    else if (mode == 1) {
#pragma unroll
                        for (int j = 0; j < 4; ++j) { v0[j] = v0[j] * sigmoidf_(v0[j]); v1[j] = v1[j] * sigmoidf_(v1[j]); } }
                    else if (mode == 3) { v0 *= C_B; v1 *= C_B; }
                    u32x4 w; w.x = cvt_pk_bf16(v0[0], v0[1]); w.y = cvt_pk_bf16(v0[2], v0[3]); w.z = cvt_pk_bf16(v1[0], v1[1]); w.w = cvt_pk_bf16(v1[2], v1[3]);
                    *(u32x4*)(rowp + bj * 128) = w; } }
    }
    __device__ __forceinline__ void hook(f32x4 (&)[2][2][4][2], const Unit&, int, int, int, int, int) const {}
};
template <int ldc> struct EpiPlain {
    static constexpr bool PERM = true, HOOK = false;
    bf16_t* O;
    __device__ __forceinline__ void operator()(const f32x4 (&acc)[2][2][4][2], const Unit& u, int wr, int wc, int, int) const {
        const int ln_ = lane_id_v(); const int fr = ln_ & 15, fq = ln_ >> 4;
        const int row0 = u.pm * 256 + wr * 64 + fr, col0 = u.pn * 256 + wc * 32 + 8 * fq;
#pragma unroll
        for (int ai = 0; ai < 2; ++ai)
#pragma unroll
            for (int m = 0; m < 4; ++m) { bf16_t* rowp = O + (size_t)(row0 + ai * 128 + m * 16) * ldc + col0;
#pragma unroll
                for (int bj = 0; bj < 2; ++bj) { const f32x4 v0 = acc[ai][bj][m][0], v1 = acc[ai][bj][m][1];
                    u32x4 w; w.x = cvt_pk_bf16(v0[0], v0[1]); w.y = cvt_pk_bf16(v0[2], v0[3]); w.z = cvt_pk_bf16(v1[0], v1[1]); w.w = cvt_pk_bf16(v1[2], v1[3]);
                    *(u32x4*)(rowp + bj * 128) = w; } }
    }
    __device__ __forceinline__ void hook(f32x4 (&)[2][2][4][2], const Unit&, int, int, int, int, int) const {}
};
struct EpiQ {
    static constexpr bool PERM = true, HOOK = false;
    bf16_t* Q; const float* sq; const float* rope; int xrow0;
    __device__ __forceinline__ void operator()(const f32x4 (&acc)[2][2][4][2], const Unit& u, int wr, int wc, int, int) const {
        const int ln_ = lane_id_v(); const int fr = ln_ & 15, fq = ln_ >> 4;
        const int row0 = u.pm * 256 + wr * 64 + fr, col0 = u.pn * 256 + wc * 32 + 8 * fq;
        const int j0 = col0 % 192, j1 = (col0 + 128) % 192;
        const int rb = j0 >= 128 ? 0 : (j1 >= 128 ? 1 : -1), jr = (rb == 0 ? j0 : j1) - 128;
        float sc[2][4]; f32x4 t0[2][4], t1[2][4];
#pragma unroll
        for (int ai = 0; ai < 2; ++ai)
#pragma unroll
            for (int m = 0; m < 4; ++m) { const int ar = xrow0 + row0 + ai * 128 + m * 16; sc[ai][m] = sq[ar] * C_A; t0[ai][m] = (f32x4){1.f, 0.f, 1.f, 0.f}; t1[ai][m] = t0[ai][m];
                if (rb >= 0) { const float* tp = rope + ((size_t)row_pos(ar) * 32 + (jr >> 1)) * 2; t0[ai][m] = *(const f32x4*)tp; t1[ai][m] = *(const f32x4*)(tp + 4); } }
#pragma unroll
        for (int ai = 0; ai < 2; ++ai)
#pragma unroll
            for (int m = 0; m < 4; ++m) { const int r = row0 + ai * 128 + m * 16; const float s = sc[ai][m];
                bf16_t* rowp = Q + (size_t)r * 1536 + col0;
#pragma unroll
                for (int bj = 0; bj < 2; ++bj) { f32x4 v0 = acc[ai][bj][m][0] * s, v1 = acc[ai][bj][m][1] * s;
                    if (bj == rb) { const f32x4 c0 = t0[ai][m], c1 = t1[ai][m];
                        f32x4 a, b;
                        a[0] = v0[0] * c0[0] - v0[1] * c0[1]; a[1] = v0[1] * c0[0] + v0[0] * c0[1]; a[2] = v0[2] * c0[2] - v0[3] * c0[3]; a[3] = v0[3] * c0[2] + v0[2] * c0[3];
                        b[0] = v1[0] * c1[0] - v1[1] * c1[1]; b[1] = v1[1] * c1[0] + v1[0] * c1[1]; b[2] = v1[2] * c1[2] - v1[3] * c1[3]; b[3] = v1[3] * c1[2] + v1[2] * c1[3];
                        v0 = a; v1 = b; }
                    u32x4 w; w.x = cvt_pk_bf16(v0[0], v0[1]); w.y = cvt_pk_bf16(v0[2], v0[3]); w.z = cvt_pk_bf16(v1[0], v1[1]); w.w = cvt_pk_bf16(v1[2], v1[3]);
                    *(u32x4*)(rowp + bj * 128) = w; } }
    }
    __device__ __forceinline__ void hook(f32x4 (&)[2][2][4][2], const Unit&, int, int, int, int, int) const {}
};
struct EpiMerge {
    static constexpr bool PERM = true, HOOK = true;
    bf16_t* O; const bf16_t* GB;
    static constexpr size_t BRS = (size_t)(GXR / 256) * 8 * 65536;
    __device__ __forceinline__ void hook(f32x4 (&acc)[2][2][4][2], const Unit& u, int which, int wr, int wc, int, int) const {
        const int ln_ = lane_id_v(); const int fr = ln_ & 15, fq = ln_ >> 4;
        int rt = wr * 64 + fr; asm volatile("" : "+v"(rt));
        const bf16_t* g1 = GB + (size_t)which * BRS + ((size_t)u.pm * 8 + u.pn) * 65536 + (size_t)rt * 256 + wc * 32 + 8 * fq;
        u32x4 a[2][2][2], b[2][2][2];
#define HK_LD(bu, st) do { _Pragma("unroll") for (int mm = 0; mm < 2; ++mm) _Pragma("unroll") for (int bj = 0; bj < 2; ++bj) { \
            const bf16_t* p = g1 + (((st) >> 1) * 128 + (((st) & 1) * 2 + mm) * 16) * 256 + bj * 128; a[bu][mm][bj] = *(const u32x4*)p; b[bu][mm][bj] = *(const u32x4*)(p + BRS); } } while (0)
#define HK_MUL(bu, st) do { _Pragma("unroll") for (int mm = 0; mm < 2; ++mm) _Pragma("unroll") for (int bj = 0; bj < 2; ++bj) { const u32x4 x = a[bu][mm][bj], y = b[bu][mm][bj]; f32x4 r0, r1; \
            r0[0] = bf_lo(x.x) * fast_rcp(fmaxf(bf_lo(y.x), 1e-30f)); r0[1] = bf_hi(x.x) * fast_rcp(fmaxf(bf_hi(y.x), 1e-30f)); \
            r0[2] = bf_lo(x.y) * fast_rcp(fmaxf(bf_lo(y.y), 1e-30f)); r0[3] = bf_hi(x.y) * fast_rcp(fmaxf(bf_hi(y.y), 1e-30f)); \
            r1[0] = bf_lo(x.z) * fast_rcp(fmaxf(bf_lo(y.z), 1e-30f)); r1[1] = bf_hi(x.z) * fast_rcp(fmaxf(bf_hi(y.z), 1e-30f)); \
            r1[2] = bf_lo(x.w) * fast_rcp(fmaxf(bf_lo(y.w), 1e-30f)); r1[3] = bf_hi(x.w) * fast_rcp(fmaxf(bf_hi(y.w), 1e-30f)); \
            acc[(st) >> 1][bj][((st) & 1) * 2 + mm][0] *= r0; acc[(st) >> 1][bj][((st) & 1) * 2 + mm][1] *= r1; } } while (0)
        HK_LD(0, 0);
        HK_LD(1, 1); asm volatile("s_waitcnt vmcnt(8)" ::: "memory"); HK_MUL(0, 0);
        HK_LD(0, 2); asm volatile("s_waitcnt vmcnt(8)" ::: "memory"); HK_MUL(1, 1);
        HK_LD(1, 3); asm volatile("s_waitcnt vmcnt(8)" ::: "memory"); HK_MUL(0, 2);
        asm volatile("s_waitcnt vmcnt(0)" ::: "memory"); HK_MUL(1, 3);
        asm volatile("" ::: "memory");
#undef HK_LD
#undef HK_MUL
    }
    __device__ __forceinline__ void operator()(const f32x4 (&acc)[2][2][4][2], const Unit& u, int wr, int wc, int, int) const {
        const int ln_ = lane_id_v(); const int fr = ln_ & 15, fq = ln_ >> 4;
        const int row0 = u.pm * 256 + wr * 64 + fr, col0 = u.pn * 256 + wc * 32 + 8 * fq;
        const bf16_t* g1 = GB + 2 * BRS + ((size_t)u.pm * 8 + u.pn) * 65536 + (size_t)(wr * 64 + fr) * 256 + wc * 32 + 8 * fq;
        u32x4 y[2][4][2];
#pragma unroll
        for (int ai = 0; ai < 2; ++ai)
#pragma unroll
            for (int m = 0; m < 4; ++m)
#pragma unroll
                for (int bj = 0; bj < 2; ++bj) y[ai][m][bj] = *(const u32x4*)(g1 + (ai * 128 + m * 16) * 256 + bj * 128);
#pragma unroll
        for (int ai = 0; ai < 2; ++ai) {
#pragma unroll
            for (int m = 0; m < 4; ++m) { bf16_t* rowp = O + (size_t)(row0 + ai * 128 + m * 16) * 2048 + col0;
#pragma unroll
                for (int bj = 0; bj < 2; ++bj) { const u32x4 g = y[ai][m][bj]; const f32x4 v0 = acc[ai][bj][m][0], v1 = acc[ai][bj][m][1];
                    u32x4 w; w.x = cvt_pk_bf16(v0[0] * bf_lo(g.x), v0[1] * bf_hi(g.x)); w.y = cvt_pk_bf16(v0[2] * bf_lo(g.y), v0[3] * bf_hi(g.y));
                    w.z = cvt_pk_bf16(v1[0] * bf_lo(g.z), v1[1] * bf_hi(g.z)); w.w = cvt_pk_bf16(v1[2] * bf_lo(g.w), v1[3] * bf_hi(g.w));
                    *(u32x4*)(rowp + bj * 128) = w; } }
            asm volatile("" ::: "memory"); }
    }
};
struct EpiGate {
    static constexpr bool PERM = true, HOOK = false;
    bf16_t* O; const float* gt; int xrow0;
    __device__ __forceinline__ void operator()(const f32x4 (&acc)[2][2][4][2], const Unit& u, int wr, int wc, int, int) const {
        const int ln_ = lane_id_v(); const int fr = ln_ & 15, fq = ln_ >> 4;
        const int row0 = u.pm * 256 + wr * 64 + fr, col0 = u.pn * 256 + wc * 32 + 8 * fq;
        const int tile_row = xrow0 + u.pm * 256;
        const float* gr = gt + (size_t)(tile_row >> 13) * NADA + col0;
        f32x4 g[2][2];
#pragma unroll
        for (int bj = 0; bj < 2; ++bj) { g[bj][0] = *(const f32x4*)(gr + bj * 128) + 1.0f; g[bj][1] = *(const f32x4*)(gr + bj * 128 + 4) + 1.0f; }
#pragma unroll
        for (int ai = 0; ai < 2; ++ai)
#pragma unroll
            for (int m = 0; m < 4; ++m) { bf16_t* op = O + (size_t)(xrow0 + row0 + ai * 128 + m * 16) * DM + col0;
#pragma unroll
                for (int bj = 0; bj < 2; ++bj) { const f32x4 v0 = acc[ai][bj][m][0] * g[bj][0], v1 = acc[ai][bj][m][1] * g[bj][1];
                    u32x4 w; w.x = cvt_pk_bf16(v0[0], v0[1]); w.y = cvt_pk_bf16(v0[2], v0[3]); w.z = cvt_pk_bf16(v1[0], v1[1]); w.w = cvt_pk_bf16(v1[2], v1[3]);
                    *(u32x4*)(op + bj * 128) = w; } }
    }
    __device__ __forceinline__ void hook(f32x4 (&)[2][2][4][2], const Unit&, int, int, int, int, int) const {}
};

__device__ __forceinline__ f32x4 mfma16(bf16x8 a, bf16x8 b, f32x4 c) { return __builtin_amdgcn_mfma_f32_16x16x32_bf16(a, b, c, 0, 0, 0); }
__device__ __forceinline__ void skinny_kloop(f32x4 (&acc)[4][4], const char* pa, const char* pb, const unsigned (&va)[4], const unsigned (&vb)[4], const int nc) {
    bf16x8 fa[2][2][4], fb[2][2][4];
#define SK_LD(bu, PA, PB) do { _Pragma("unroll") for (int k_ = 0; k_ < 2; ++k_) _Pragma("unroll") for (int i_ = 0; i_ < 4; ++i_) { fa[bu][k_][i_] = *(const bf16x8*)((PA) + va[i_] + k_ * 64); fb[bu][k_][i_] = *(const bf16x8*)((PB) + vb[i_] + k_ * 64); } } while (0)
#define SK_MM(bu) do { _Pragma("unroll") for (int k_ = 0; k_ < 2; ++k_) _Pragma("unroll") for (int m_ = 0; m_ < 4; ++m_) _Pragma("unroll") for (int n_ = 0; n_ < 4; ++n_) acc[m_][n_] = mfma16(fb[bu][k_][n_], fa[bu][k_][m_], acc[m_][n_]); } while (0)
    SK_LD(0, pa, pb);
#pragma unroll 1
    for (int c = 0; c < nc; c += 2) {
        const int o1 = (c + 1 < nc) ? 128 : 0, o2 = (c + 2 < nc) ? 256 : 0;
        SK_LD(1, pa + o1, pb + o1);
        SK_MM(0);
        SK_LD(0, pa + o2, pb + o2);
        if (c + 1 < nc) SK_MM(1);
        pa += 256; pb += 256;
    }
#undef SK_LD
#undef SK_MM
}
struct SkNoPre { __device__ __forceinline__ void operator()(f32x4 (&)[4][4], int, int, int, int) const {} };
struct SkGateFin {
    bf16_t* O; const float* gt;
    __device__ __forceinline__ void operator()(int r, int c, const f32x4& s) const { const int ar = MP + r; const f32x4 g = *(const f32x4*)(gt + (size_t)row_stream(ar) * NADA + c) + 1.0f; const f32x4 v = s * g;
        *(u32x2*)(O + (size_t)ar * DM + c) = (u32x2){cvt_pk_bf16(v[0], v[1]), cvt_pk_bf16(v[2], v[3])}; }
};
struct SkMergePre {
    const bf16_t* GB; int br;
    __device__ __forceinline__ void operator()(f32x4 (&acc)[4][4], int row0, int col0, int fr, int fq) const {
        const bf16_t* g0 = GB + (size_t)br * EpiMerge::BRS + ((size_t)(GPR / 256 + (row0 >> 8)) * 8 + (col0 >> 8)) * 65536 + (size_t)((row0 & 255) + fr) * 256 + (col0 & 255) + 4 * fq;
        u32x2 gw[4][4];
#pragma unroll
        for (int m = 0; m < 4; ++m)
#pragma unroll
            for (int n = 0; n < 4; ++n) gw[m][n] = *(const u32x2*)(g0 + m * 16 * 256 + n * 16);
#pragma unroll
        for (int m = 0; m < 4; ++m)
#pragma unroll
            for (int n = 0; n < 4; ++n) { const u32x2 g = gw[m][n]; acc[m][n] *= (f32x4){bf_lo(g.x), bf_hi(g.x), bf_lo(g.y), bf_hi(g.y)}; }
    }
};
struct SkMergeFin { bf16_t* O;
    __device__ __forceinline__ void operator()(int r, int c, const f32x4& s) const { *(u32x2*)(O + (size_t)(GPR + r) * 2048 + c) = (u32x2){cvt_pk_bf16(s[0], s[1]), cvt_pk_bf16(s[2], s[3])}; }
};
template <class Pre, class Fin>
__device__ __forceinline__ void skinny_tiles(const int tid, LAS unsigned char* lds, const bf16_t* A, const int lda, const bf16_t* Bt, const int ldb, const int kch0, const int nc, const int G, const int bid, const Pre& pre, const Fin& fin) {
    const int lane = tid & 63, w = __builtin_amdgcn_readfirstlane(tid >> 6), fr = lane & 15, fq = lane >> 4;
    LAS f32x4* red = (LAS f32x4*)lds;
    unsigned va[4], vb[4];
#pragma unroll
    for (int i = 0; i < 4; ++i) { va[i] = (unsigned)((16 * i + fr) * lda + 8 * fq) * 2u; vb[i] = (unsigned)((16 * i + fr) * ldb + 8 * fq) * 2u; }
    for (int t = bid; t < 256; t += G) {
        const int x = t & 7, j = t >> 3, row0 = (j >> 2) * 64, col0 = (x * 4 + (j & 3)) * 64;
        f32x4 acc[4][4];
#pragma unroll
        for (int m = 0; m < 4; ++m)
#pragma unroll
            for (int n = 0; n < 4; ++n) acc[m][n] = (f32x4){0.f, 0.f, 0.f, 0.f};
        skinny_kloop(acc, (const char*)(A + (size_t)row0 * lda + kch0 * 64), (const char*)(Bt + (size_t)col0 * ldb + kch0 * 64), va, vb, nc);
        pre(acc, row0, col0, fr, fq);
#pragma unroll
        for (int m = 0; m < 4; ++m)
#pragma unroll
            for (int n = 0; n < 4; ++n) red[(w * 16 + m * 4 + n) * 64 + lane] = acc[m][n];
        __syncthreads();
#pragma unroll
        for (int i = 0; i < 2; ++i) { const int f = tid + 512 * i; f32x4 s = red[f];
#pragma unroll
            for (int ww = 1; ww < 8; ++ww) s += red[ww * 1024 + f];
            const int tl = f >> 6, ln = f & 63; fin(row0 + 16 * (tl >> 2) + (ln & 15), col0 + 16 * (tl & 3) + 4 * (ln >> 4), s); }
        __syncthreads();
    }
}

__device__ __forceinline__ float dpp_ror1(float v) { return __int_as_float(__builtin_amdgcn_mov_dpp(__float_as_int(v), 0x121, 0xF, 0xF, false)); }
__device__ __forceinline__ float dpp_ror2(float v) { return __int_as_float(__builtin_amdgcn_mov_dpp(__float_as_int(v), 0x122, 0xF, 0xF, false)); }
__device__ __forceinline__ float dpp_shr1(float old, float v) { return __int_as_float(__builtin_amdgcn_update_dpp(__float_as_int(old), __float_as_int(v), 0x111, 0xF, 0xF, false)); }
__device__ __forceinline__ float dpp_shr2(float old, float v) { return __int_as_float(__builtin_amdgcn_update_dpp(__float_as_int(old), __float_as_int(v), 0x112, 0xF, 0xF, false)); }
__device__ __forceinline__ f32x2 gelu2(f32x2 v) {
    const f32x2 av = {fabsf(v[0]), fabsf(v[1])}, rl = {fmaxf(v[0], 0.f), fmaxf(v[1], 0.f)};
    const f32x2 d = av * 0.2316418882f + 1.0f;
    const f32x2 t = {__builtin_amdgcn_rcpf(d[0]), __builtin_amdgcn_rcpf(d[1])};
    f32x2 q = t * 0.5307027145f + (-0.7265760135f); q = q * t + 0.7107068705f; q = q * t + (-0.142248368f); q = q * t + 0.127414796f; q = q * t;
    const f32x2 ea = (v * v) * (-0.72134752044f);
    const f32x2 e = {__builtin_amdgcn_exp2f(ea[0]), __builtin_amdgcn_exp2f(ea[1])};
    return rl - av * (q * e);
}
struct EpiConv {
    static constexpr bool PERM = true, HOOK = false;
    bf16_t* U; bf16_t* side; const float* cw; const float* cb;
    __device__ __forceinline__ void operator()(const f32x4 (&acc)[2][2][4][2], const Unit& u, int wr, int wc, int, int) const {
        const int ln_ = lane_id_v(); const int fr = ln_ & 15, fq = ln_ >> 4;
        const int row0 = u.pm * 256 + wr * 64 + fr, f0 = u.pn * 128 + wc * 32 + 8 * fq;
        const bool samp = u.pm * 256 >= MP;
        f32x2 w0[4], w1[4], w2[4], bb[4];
        { const f32x4 a0 = *(const f32x4*)(cw + f0), a1 = *(const f32x4*)(cw + f0 + 4), b0 = *(const f32x4*)(cw + DFF + f0), b1 = *(const f32x4*)(cw + DFF + f0 + 4);
          const f32x4 c0 = *(const f32x4*)(cw + 2 * DFF + f0), c1 = *(const f32x4*)(cw + 2 * DFF + f0 + 4), d0 = *(const f32x4*)(cb + f0), d1 = *(const f32x4*)(cb + f0 + 4);
          w0[0] = (f32x2){a0[0], a0[1]}; w0[1] = (f32x2){a0[2], a0[3]}; w0[2] = (f32x2){a1[0], a1[1]}; w0[3] = (f32x2){a1[2], a1[3]};
          w1[0] = (f32x2){b0[0], b0[1]}; w1[1] = (f32x2){b0[2], b0[3]}; w1[2] = (f32x2){b1[0], b1[1]}; w1[3] = (f32x2){b1[2], b1[3]};
          w2[0] = (f32x2){c0[0], c0[1]}; w2[1] = (f32x2){c0[2], c0[3]}; w2[2] = (f32x2){c1[0], c1[1]}; w2[3] = (f32x2){c1[2], c1[3]};
          bb[0] = (f32x2){d0[0], d0[1]}; bb[1] = (f32x2){d0[2], d0[3]}; bb[2] = (f32x2){d1[0], d1[1]}; bb[3] = (f32x2){d1[2], d1[3]}; }
#pragma unroll
        for (int ai = 0; ai < 2; ++ai) {
            float p1[8], p2[8];
#pragma unroll
            for (int j = 0; j < 8; ++j) { p1[j] = 0.f; p2[j] = 0.f; }
#pragma unroll
            for (int m = 0; m < 4; ++m) { const int r = row0 + ai * 128 + m * 16;
                float a[8], b[8], am1[8], am2[8];
#pragma unroll
                for (int j = 0; j < 4; ++j) { a[j] = acc[ai][0][m][0][j]; a[4 + j] = acc[ai][0][m][1][j]; b[j] = acc[ai][1][m][0][j]; b[4 + j] = acc[ai][1][m][1][j]; }
#pragma unroll
                for (int j = 0; j < 8; ++j) { am1[j] = dpp_shr1(p1[j], a[j]); am2[j] = dpp_shr2(p2[j], a[j]); }
                if (m < 3) {
#pragma unroll
                    for (int j = 0; j < 8; ++j) { p1[j] = dpp_ror1(a[j]); p2[j] = dpp_ror2(a[j]); } }
                u32x4 w;
#pragma unroll
                for (int jp = 0; jp < 4; ++jp) { const f32x2 A = {a[2 * jp], a[2 * jp + 1]}, A1 = {am1[2 * jp], am1[2 * jp + 1]}, A2 = {am2[2 * jp], am2[2 * jp + 1]}, B = {b[2 * jp], b[2 * jp + 1]};
                    const f32x2 pre = bb[jp] + A2 * w0[jp] + A1 * w1[jp] + A * w2[jp];
                    const f32x2 g = gelu2(pre) * B; w[jp] = cvt_pk_bf16(g[0], g[1]); }
                *(u32x4*)(U + (size_t)r * DFF + f0) = w;
                const bool first = samp || m == 0, lastg = samp || m == 3;
                if ((first && fr < 2) || (lastg && fr >= 14)) { bf16_t* sp = side + (size_t)(r >> 4) * 6 * DFF + f0;
                    u32x4 wa; wa.x = cvt_pk_bf16(a[0], a[1]); wa.y = cvt_pk_bf16(a[2], a[3]); wa.z = cvt_pk_bf16(a[4], a[5]); wa.w = cvt_pk_bf16(a[6], a[7]);
                    if (first && fr < 2) { u32x4 wb; wb.x = cvt_pk_bf16(b[0], b[1]); wb.y = cvt_pk_bf16(b[2], b[3]); wb.z = cvt_pk_bf16(b[4], b[5]); wb.w = cvt_pk_bf16(b[6], b[7]);
                        *(u32x4*)(sp + (size_t)fr * DFF) = wa; *(u32x4*)(sp + (size_t)(2 + fr) * DFF) = wb; }
                    if (lastg && fr >= 14) *(u32x4*)(sp + (size_t)(4 + fr - 14) * DFF) = wa; }
            }
        }
    }
    __device__ __forceinline__ void hook(f32x4 (&)[2][2][4][2], const Unit&, int, int, int, int, int) const {}
};

constexpr int AT_KBUF = 25600, AT_VBUF0 = 51200, AT_VBYTES = 17408, AT_BIAS = 86016, AT_VSTR = 136;
__device__ __forceinline__ f32x16 mfma32(bf16x8 a, bf16x8 b, f32x16 c) { return __builtin_amdgcn_mfma_f32_32x32x16_bf16(a, b, c, 0, 0, 0); }
__device__ __forceinline__ float xhalf_max(float v) { auto rr = __builtin_amdgcn_permlane32_swap(__float_as_uint(v), __float_as_uint(v), false, false); return fmaxf(__uint_as_float(rr[0]), __uint_as_float(rr[1])); }
__device__ __forceinline__ float xhalf_sum(float v) { auto rr = __builtin_amdgcn_permlane32_swap(__float_as_uint(v), __float_as_uint(v), false, false); return __uint_as_float(rr[0]) + __uint_as_float(rr[1]); }
__device__ __forceinline__ bf16x8 pack8f(const f32x16& p, int base) {
    u32x4 w; w.x = cvt_pk_bf16(p[base + 0], p[base + 1]); w.y = cvt_pk_bf16(p[base + 2], p[base + 3]); w.z = cvt_pk_bf16(p[base + 4], p[base + 5]); w.w = cvt_pk_bf16(p[base + 6], p[base + 7]);
    return *reinterpret_cast<bf16x8*>(&w);
}

struct MlaLoader {
    unsigned tid; const char* kn; const char* kr; const char* vt; int nkeys;
    u32x4 rk[3], rv[2];
    __device__ __forceinline__ void load(int t) {
        unsigned tid = this->tid; asm volatile("" : "+v"(tid));
        const char* knt = kn + (size_t)t * (64 * 2048); const char* krt = kr + (size_t)t * (64 * 128); const char* vtt = vt + (size_t)t * 128;
#pragma unroll
        for (int i = 0; i < 2; ++i) { const unsigned c = tid + 512u * i; rk[i] = *(const u32x4*)(knt + ((c >> 4) * 2048u + (c & 15u) * 16u)); }
        rk[2] = *(const u32x4*)(krt + ((tid >> 3) * 128u + (tid & 7u) * 16u));
#pragma unroll
        for (int i = 0; i < 2; ++i) { const unsigned c = tid + 512u * i; rv[i] = *(const u32x4*)(vtt + ((c >> 3) * (unsigned)(VT_LD * 2) + (c & 7u) * 16u)); }
        if ((t + 1) * 64 > nkeys) {
#pragma unroll
            for (int i = 0; i < 2; ++i) { const unsigned c = tid + 512u * i; if (t * 64 + (int)(c & 7u) * 8 >= nkeys) rv[i] = (u32x4){0u, 0u, 0u, 0u}; } }
    }
    __device__ __forceinline__ void store(LAS unsigned char* kb, LAS unsigned char* vb) const {
        unsigned tid = this->tid; asm volatile("" : "+v"(tid));
#pragma unroll
        for (int i = 0; i < 2; ++i) { const unsigned c = tid + 512u * i; *(LAS u32x4*)(kb + (c >> 4) * 400u + (c & 15u) * 16u) = rk[i]; }
        *(LAS u32x4*)(kb + (tid >> 3) * 400u + 256u + (tid & 7u) * 16u) = rk[2];
#pragma unroll
        for (int i = 0; i < 2; ++i) { const unsigned c = tid + 512u * i; LAS unsigned char* d = vb + (c >> 3) * (unsigned)AT_VSTR + (c & 7u) * 16u;
            *(LAS u32x2*)d = (u32x2){rv[i].x, rv[i].y}; *(LAS u32x2*)(d + 8) = (u32x2){rv[i].z, rv[i].w}; }
    }
};
struct BandLoader {
    unsigned tid; const char* kc; const char* vc; int ncache;
    const char* kp; const char* vp; int nkeys;
    u32x4 rk[2], rv[2];
    __device__ __forceinline__ void load(int t) {
        unsigned tid = this->tid; asm volatile("" : "+v"(tid));
        const unsigned kpair = tid & 31u, vpart = tid >> 5;
        if (t * 64 < ncache) {
            const char* kt = kc + (size_t)t * (64 * 4096); const char* vtt = vc + (size_t)t * (64 * 4096);
#pragma unroll
            for (int i = 0; i < 2; ++i) { const unsigned c = tid + 512u * i; const char* s = kt + ((c >> 4) * 4096u + (c & 15u) * 32u); const f32x4 a = *(const f32x4*)s, b = *(const f32x4*)(s + 16);
                rk[i] = (u32x4){cvt_pk_bf16(a[0], a[1]), cvt_pk_bf16(a[2], a[3]), cvt_pk_bf16(b[0], b[1]), cvt_pk_bf16(b[2], b[3])}; }
#pragma unroll
            for (int i = 0; i < 2; ++i) { const char* s = vtt + ((2u * kpair + i) * 4096u + vpart * 32u); const f32x4 a = *(const f32x4*)s, b = *(const f32x4*)(s + 16);
                rv[i] = (u32x4){cvt_pk_bf16(a[0], a[1]), cvt_pk_bf16(a[2], a[3]), cvt_pk_bf16(b[0], b[1]), cvt_pk_bf16(b[2], b[3])}; }
        } else {
            const int k0 = t * 64 - ncache; const char* kt = kp + (size_t)k0 * (NPROJ * 2); const char* vtt = vp + (size_t)k0 * (NPROJ * 2);
#pragma unroll
            for (int i = 0; i < 2; ++i) { const unsigned c = tid + 512u * i; rk[i] = *(const u32x4*)(kt + ((c >> 4) * (unsigned)(NPROJ * 2) + (c & 15u) * 16u)); }
#pragma unroll
            for (int i = 0; i < 2; ++i) rv[i] = *(const u32x4*)(vtt + ((2u * kpair + i) * (unsigned)(NPROJ * 2) + vpart * 16u));
            if ((t + 1) * 64 > nkeys) {
#pragma unroll
                for (int i = 0; i < 2; ++i) if (t * 64 + (int)(2u * kpair) + i >= nkeys) rv[i] = (u32x4){0u, 0u, 0u, 0u}; }
        }
    }
    __device__ __forceinline__ void store(LAS unsigned char* kb, LAS unsigned char* vb) const {
        unsigned tid = this->tid; asm volatile("" : "+v"(tid));
#pragma unroll
        for (int i = 0; i < 2; ++i) { const unsigned c = tid + 512u * i; *(LAS u32x4*)(kb + (c >> 4) * 272u + (c & 15u) * 16u) = rk[i]; }
        const unsigned kpair = tid & 31u, part = tid >> 5; LAS unsigned char* d = vb + (part * 8u) * (unsigned)AT_VSTR + kpair * 4u;
        const unsigned a[4] = {rv[0].x, rv[0].y, rv[0].z, rv[0].w}, b[4] = {rv[1].x, rv[1].y, rv[1].z, rv[1].w};
#pragma unroll
        for (int e = 0; e < 4; ++e) { *(LAS unsigned*)(d + (2 * e) * AT_VSTR) = (a[e] & 0xffffu) | (b[e] << 16); *(LAS unsigned*)(d + (2 * e + 1) * AT_VSTR) = (a[e] >> 16) | (b[e] & 0xffff0000u); }
    }
};

template <int DQK, bool BIAS, class Loader>
__device__ __forceinline__ void attn_unit(const int tid, LAS unsigned char* lds, Loader& L, const bf16_t* qptr, bool wave_active, int t0, int t1, int wt0, int wt1, int nkeys, int qpos, int kpos0, bf16_t* optr) {
    constexpr int NKS = DQK / 16, KSTR = DQK * 2 + 16;
    const int lane = tid & 63, l31 = lane & 31, hi = lane >> 5;
    bf16x8 qf[NKS];
#pragma unroll
    for (int ks = 0; ks < NKS; ++ks) qf[ks] = *(const bf16x8*)(qptr + ks * 16 + hi * 8);
    f32x16 o0, o1, o2, o3;
#pragma unroll
    for (int r = 0; r < 16; ++r) { o0[r] = 0.f; o1[r] = 0.f; o2[r] = 0.f; o3[r] = 0.f; }
    float m_run = -1e30f, l_run = 0.f;
    L.load(t0); L.store(lds, lds + AT_VBUF0); if (t0 + 1 < t1) L.load(t0 + 1); __syncthreads();
    for (int t = t0; t < t1; ++t) {
        const int cur = (t - t0) & 1;
        if (t + 1 < t1) L.store(lds + (cur ^ 1) * AT_KBUF, lds + AT_VBUF0 + (cur ^ 1) * AT_VBYTES);
        if (t + 2 < t1) L.load(t + 2);
        if (wave_active && t >= wt0 && t < wt1) {
            const LAS unsigned char* kb = lds + cur * AT_KBUF + l31 * KSTR + hi * 16;
            const LAS unsigned char* vb = lds + AT_VBUF0 + cur * AT_VBYTES + l31 * AT_VSTR + hi * 8;
            f32x16 sv[2];
#pragma unroll
            for (int r = 0; r < 16; ++r) { sv[0][r] = 0.f; sv[1][r] = 0.f; }
            constexpr int KG = (DQK == 192 ? 6 : 4), NG2 = 2 * NKS / KG;
            bf16x8 kfa[KG], kfb[KG];
#define AT_LDK(dst, g) { _Pragma("unroll") for (int j_ = 0; j_ < KG; ++j_) { const int idx_ = (g) * KG + j_, kh_ = idx_ / NKS, ks_ = idx_ % NKS; dst[j_] = *(const LAS bf16x8*)(kb + kh_ * 32 * KSTR + ks_ * 32); } }
#define AT_MMK(src, g) { __builtin_amdgcn_s_setprio(1); _Pragma("unroll") for (int j_ = 0; j_ < KG; ++j_) { const int idx_ = (g) * KG + j_, kh_ = idx_ / NKS, ks_ = idx_ % NKS; sv[kh_] = mfma32(src[j_], qf[ks_], sv[kh_]); } __builtin_amdgcn_s_setprio(0); }
            AT_LDK(kfa, 0)
#pragma unroll
            for (int g = 0; g < NG2; g += 2) {
                if (g + 1 < NG2) AT_LDK(kfb, g + 1)
                __builtin_amdgcn_sched_barrier(0);
                AT_MMK(kfa, g)
                __builtin_amdgcn_sched_barrier(0);
                if (g + 2 < NG2) AT_LDK(kfa, g + 2)
                __builtin_amdgcn_sched_barrier(0);
                if (g + 1 < NG2) AT_MMK(kfb, g + 1)
                __builtin_amdgcn_sched_barrier(0);
            }
#undef AT_LDK
#undef AT_MMK
            bf16x8 vfa[4], vfb[4];
#define AT_LDV(dst, s_) { _Pragma("unroll") for (int db_ = 0; db_ < 4; ++db_) { const u32x2 a_ = *(const LAS u32x2*)(vb + db_ * 32 * AT_VSTR + (s_) * 32), b_ = *(const LAS u32x2*)(vb + db_ * 32 * AT_VSTR + (s_) * 32 + 16); u32x4 w_ = {a_.x, a_.y, b_.x, b_.y}; dst[db_] = *reinterpret_cast<bf16x8*>(&w_); } }
#define AT_MMV(src, pf_) { __builtin_amdgcn_s_setprio(1); o0 = mfma32(src[0], pf_, o0); o1 = mfma32(src[1], pf_, o1); o2 = mfma32(src[2], pf_, o2); o3 = mfma32(src[3], pf_, o3); __builtin_amdgcn_s_setprio(0); }
            AT_LDV(vfa, 0)
#pragma unroll
            for (int kh = 0; kh < 2; ++kh) {
                f32x16& s = sv[kh];
                if (BIAS) { const LAS float* bt = (const LAS float*)(lds + AT_BIAS); const int d0 = qpos - (kpos0 + t * 64 + kh * 32) - 4 * hi;
                    if (__builtin_amdgcn_readfirstlane(qpos) - (kpos0 + t * 64 + kh * 32 + 31) >= 128) { const float bc = bt[256];
#pragma unroll
                        for (int r = 0; r < 16; ++r) s[r] += bc; }
                    else {
#pragma unroll
                        for (int r = 0; r < 16; ++r) { const int c = (r & 3) + 8 * (r >> 2); int da = d0 - c; da = (da < -128 ? -128 : (da > 128 ? 128 : da)) + 128; s[r] += bt[da]; } } }
                if ((t + 1) * 64 > nkeys) { const int kb0 = t * 64 + kh * 32 + 4 * hi; const float NEG = -__builtin_inff();
#pragma unroll
                    for (int r = 0; r < 16; ++r) { const int c = (r & 3) + 8 * (r >> 2); if (kb0 + c >= nkeys) s[r] = NEG; } }
                float pmax = s[0];
#pragma unroll
                for (int r = 1; r < 16; ++r) pmax = fmaxf(pmax, s[r]);
                pmax = xhalf_max(pmax);
                if (!__all((pmax - m_run) <= 8.0f)) { const float mn = fmaxf(m_run, pmax), alpha = __builtin_amdgcn_exp2f(m_run - mn); m_run = mn; l_run *= alpha;
#pragma unroll
                    for (int r = 0; r < 16; ++r) { o0[r] *= alpha; o1[r] *= alpha; o2[r] *= alpha; o3[r] *= alpha; } }
                float ps = 0.f;
#pragma unroll
                for (int r = 0; r < 16; ++r) { s[r] = __builtin_amdgcn_exp2f(s[r] - m_run); ps += s[r]; }
                l_run += xhalf_sum(ps);
                const bf16x8 pf0 = pack8f(s, 0), pf1 = pack8f(s, 8);
                __builtin_amdgcn_sched_barrier(0);
                AT_LDV(vfb, kh * 2 + 1)
                __builtin_amdgcn_sched_barrier(0);
                AT_MMV(vfa, pf0)
                __builtin_amdgcn_sched_barrier(0);
                if (kh == 0) AT_LDV(vfa, 2)
                __builtin_amdgcn_sched_barrier(0);
                AT_MMV(vfb, pf1)
                __builtin_amdgcn_sched_barrier(0);
            }
#undef AT_LDV
#undef AT_MMV
        }
        __syncthreads();
    }
    if (optr) { const float inv = 1.0f / l_run;
#pragma unroll
        for (int g = 0; g < 4; ++g) { bf16_t* p = optr + 8 * g + 4 * hi;
            *(u32x2*)(p)      = (u32x2){cvt_pk_bf16(o0[4 * g] * inv, o0[4 * g + 1] * inv), cvt_pk_bf16(o0[4 * g + 2] * inv, o0[4 * g + 3] * inv)};
            *(u32x2*)(p + 32) = (u32x2){cvt_pk_bf16(o1[4 * g] * inv, o1[4 * g + 1] * inv), cvt_pk_bf16(o1[4 * g + 2] * inv, o1[4 * g + 3] * inv)};
            *(u32x2*)(p + 64) = (u32x2){cvt_pk_bf16(o2[4 * g] * inv, o2[4 * g + 1] * inv), cvt_pk_bf16(o2[4 * g + 2] * inv, o2[4 * g + 3] * inv)};
            *(u32x2*)(p + 96) = (u32x2){cvt_pk_bf16(o3[4 * g] * inv, o3[4 * g + 1] * inv), cvt_pk_bf16(o3[4 * g + 2] * inv, o3[4 * g + 3] * inv)}; } }
}

constexpr int RT_Q = 0, RT_K = 9216, RT_V = 18432, RT_RED = 35840, RT_QSTR = 144, RT_VSTR = 272;
constexpr int RT_BUF = 38912;
struct RetRegs { u32x4 k, q, v0, v1; };
__device__ __forceinline__ RetRegs ret_fetch(const int tid, const bf16_t* prow0, int nvalid, int h, bool withq) {
    RetRegs R; unsigned z0 = 0u; asm volatile("" : "+v"(z0)); const u32x4 z = {z0, z0, z0, z0};
    { const int row = tid >> 3, part = tid & 7; const bool ok = row < nvalid; const bf16_t* p = prow0 + (size_t)row * NPROJ + h * 64 + part * 8;
      R.k = ok ? *(const u32x4*)(p + PC_KRR) : z; R.q = (withq && ok) ? *(const u32x4*)(p + PC_QR) : z; }
    { const int row = tid >> 4, part = tid & 15; const bf16_t* p = prow0 + (size_t)row * NPROJ + PC_VR + h * 128 + part * 8;
      R.v0 = row < nvalid ? *(const u32x4*)p : z; R.v1 = (row + 32) < nvalid ? *(const u32x4*)(p + (size_t)32 * NPROJ) : z; }
    return R;
}
__device__ __forceinline__ void ret_put(const int tid, LAS unsigned char* lds, const RetRegs& R, bool withq) {
    { const int row = tid >> 3, part = tid & 7; *(LAS u32x4*)(lds + RT_K + row * RT_QSTR + part * 16) = R.k; if (withq) *(LAS u32x4*)(lds + RT_Q + row * RT_QSTR + part * 16) = R.q; }
    { const int row = tid >> 4, part = tid & 15; *(LAS u32x4*)(lds + RT_V + row * RT_VSTR + part * 16) = R.v0; *(LAS u32x4*)(lds + RT_V + (row + 32) * RT_VSTR + part * 16) = R.v1; }
}
__device__ __forceinline__ void ret_load(const int tid, LAS unsigned char* lds, const bf16_t* prow0, int nvalid, int h, bool withq) { const RetRegs R = ret_fetch(tid, prow0, nvalid, h, withq); ret_put(tid, lds, R, withq); }
__device__ __forceinline__ bf16x8 lds_col8(const LAS unsigned char* base, int stride, const int (&tok)[8]) {
    bf16x8 r;
#pragma unroll
    for (int j = 0; j < 8; ++j) r[j] = (short)*(const LAS unsigned short*)(base + tok[j] * stride);
    return r;
}
__device__ __forceinline__ f32x16 ret_state(const int tid, const LAS unsigned char* lds, int eb, int dbk) {
    const int lane = tid & 63, l31 = lane & 31, hi = lane >> 5;
    f32x16 acc;
#pragma unroll
    for (int r = 0; r < 16; ++r) acc[r] = 0.f;
#pragma unroll
    for (int ks = 0; ks < 4; ++ks) { int tok[8];
#pragma unroll
        for (int j = 0; j < 8; ++j) tok[j] = 16 * ks + 8 * hi + j;
        const bf16x8 a = lds_col8(lds + RT_V + (32 * eb + l31) * 2, RT_VSTR, tok), b = lds_col8(lds + RT_K + (32 * dbk + l31) * 2, RT_QSTR, tok);
        acc = mfma32(a, b, acc); }
    return acc;
}
__device__ __forceinline__ f32x16 ret_out(const int tid, const LAS unsigned char* lds, int eb, int qbk, float ginvL, const bf16x8 (&sf)[4]) {
    const int lane = tid & 63, l31 = lane & 31, hi = lane >> 5;
    bf16x8 qf[4];
#pragma unroll
    for (int ks = 0; ks < 4; ++ks) qf[ks] = *(const LAS bf16x8*)(lds + RT_Q + (32 * qbk + l31) * RT_QSTR + ks * 32 + hi * 16);
    f32x16 s0, s1, acc;
#pragma unroll
    for (int r = 0; r < 16; ++r) { s0[r] = 0.f; s1[r] = 0.f; acc[r] = 0.f; }
#pragma unroll
    for (int ks = 0; ks < 4; ++ks) { const bf16x8 k0 = *(const LAS bf16x8*)(lds + RT_K + l31 * RT_QSTR + ks * 32 + hi * 16), k1 = *(const LAS bf16x8*)(lds + RT_K + (32 + l31) * RT_QSTR + ks * 32 + hi * 16);
        s0 = mfma32(k0, qf[ks], s0); s1 = mfma32(k1, qf[ks], s1); }
    const int qi = 32 * qbk + l31;
#pragma unroll
    for (int r = 0; r < 16; ++r) { const int j = (r & 3) + 8 * (r >> 2) + 4 * hi; s0[r] = (j <= qi) ? s0[r] * ginvL : 0.f; s1[r] = (j + 32 <= qi) ? s1[r] * ginvL : 0.f; }
#pragma unroll
    for (int s = 0; s < 4; ++s) { const bf16x8 pf = pack8f(s < 2 ? s0 : s1, 8 * (s & 1)); int tok[8];
#pragma unroll
        for (int j = 0; j < 8; ++j) tok[j] = 16 * s + 8 * (j >> 2) + 4 * hi + (j & 3);
        const bf16x8 a = lds_col8(lds + RT_V + (32 * eb + l31) * 2, RT_VSTR, tok);
        acc = mfma32(a, pf, acc); }
#pragma unroll
    for (int ks = 0; ks < 4; ++ks) acc = mfma32(sf[ks], qf[ks], acc);
    return acc;
}
struct RetGate { f32x4 gn[4]; u32x2 gw[4]; };
__device__ __forceinline__ RetGate ret_gate_load(const float* grn_h, const bf16_t* gate_row  , bool valid, int eb, const int tid) {
    const int hi = (tid & 63) >> 5; RetGate G;
#pragma unroll
    for (int g = 0; g < 4; ++g) { G.gn[g] = (f32x4){0.f, 0.f, 0.f, 0.f}; G.gw[g] = (u32x2){0u, 0u}; }
    if (valid) {
#pragma unroll
        for (int g = 0; g < 4; ++g) { const int e0 = 32 * eb + 8 * g + 4 * hi; G.gn[g] = *(const f32x4*)(grn_h + e0); G.gw[g] = *(const u32x2*)(gate_row + e0); } }
    return G;
}
__device__ __forceinline__ void ret_finish(LAS unsigned char* lds, const f32x16& acc, int eb, int qbk, const RetGate& RG, bf16_t* out_row  , const int tid) {
    const int lane = tid & 63, l31 = lane & 31, hi = lane >> 5;
    float ps = 0.f, pq = 0.f;
#pragma unroll
    for (int r = 0; r < 16; ++r) { ps += acc[r]; pq += acc[r] * acc[r]; }
    ps = xhalf_sum(ps); pq = xhalf_sum(pq);
    LAS f32x2* red = (LAS f32x2*)(lds + RT_RED);
    if (hi == 0) red[(qbk * 4 + eb) * 32 + l31] = (f32x2){ps, pq};
    __syncthreads();
    float sum = 0.f, sq = 0.f;
#pragma unroll
    for (int e = 0; e < 4; ++e) { const f32x2 v = red[(qbk * 4 + e) * 32 + l31]; sum += v.x; sq += v.y; }
    const float mean = sum * (1.0f / 128.0f), var = fmaxf(sq * (1.0f / 128.0f) - mean * mean, 0.f), rstd = rsqrtf(var + EPS);
    if (out_row) {
#pragma unroll
        for (int g = 0; g < 4; ++g) { const int e0 = 32 * eb + 8 * g + 4 * hi; const f32x4 gn = RG.gn[g]; const u32x2 gw = RG.gw[g];
            const float y0 = (acc[4 * g] - mean) * rstd * gn[0] * bf_lo(gw.x), y1 = (acc[4 * g + 1] - mean) * rstd * gn[1] * bf_hi(gw.x);
            const float y2 = (acc[4 * g + 2] - mean) * rstd * gn[2] * bf_lo(gw.y), y3 = (acc[4 * g + 3] - mean) * rstd * gn[3] * bf_hi(gw.y);
            *(u32x2*)(out_row + e0) = (u32x2){cvt_pk_bf16(y0, y1), cvt_pk_bf16(y2, y3)}; } }
}

constexpr int LDS_MAIN = 131072, LDS_MISC = LDS_MAIN, LDS_BYTES = LDS_MAIN + 1024;

struct Grp { int xr0, nxr, kv0, nkv, b0; bool samp; };
__device__ __forceinline__ Grp make_grp(int g) { Grp r; r.xr0 = g * GPR; r.samp = (g == NG - 1); r.nxr = r.samp ? GXR : GPR; r.kv0 = r.xr0; r.nkv = r.samp ? GKV : GPR; r.b0 = g * GNB; return r; }

__device__ __forceinline__ float wsrc(const float* src, const float* gq, int task, int l, int n, int k) {
    switch (task) {
    case 0: { int sc;
        if (n < 768) sc = n;
        else if (n < 832) { const int p = n - 768; sc = 768 + (p & 1) * 32 + (p >> 1); }
        else if (n < 1024) return 0.f;
        else if (n >= PC_QR && n < PC_VR) { const int q = n - PC_QR, hh = q >> 6, p = q & 63; sc = (PC_QR - 192) + (hh << 6) + (p & 1) * 32 + (p >> 1); }
        else sc = n - 192;
        return src[((size_t)l * 2048 + k) * NIN_SRC + sc]; }
    case 1: { const int hh = n / 192, j = n % 192; const int sc = j < 128 ? n : hh * 192 + 128 + ((j - 128) & 1) * 32 + ((j - 128) >> 1);
        return gq[l * 512 + k] * src[((size_t)l * 512 + k) * 1536 + sc]; }
    case 2: return src[((size_t)l * 256 + k) * 2048 + (n >> 7) * 256 + (n & 127)];
    case 3: return src[((size_t)l * 256 + k) * 2048 + (n >> 7) * 256 + 128 + (n & 127)];
    case 4: { const int kk = k & 1023; return src[((size_t)l * 1024 + kk) * 2048 + n]; }
    case 5: return src[((size_t)l * 2048 + k) * 2048 + n];
    case 6: return src[((size_t)l * 2048 + k) * DFF + (n >> 8) * 128 + (n & 127)];
    default: return src[((size_t)l * DFF + k) * 2048 + n];
    }
}
constexpr int WC_TILES = 6656 + 192 + 64 + 64 + 1536 + 1024 + 5632 + 2816;
struct WcTile { int task, K, n0, k0, srci; size_t dst; };
__device__ __forceinline__ WcTile wconv_decode(int u) {
    WcTile t; int rem = u;
    if (rem < 6656) { t.task = 0; t.K = 2048; t.dst = WT_IN; }
    else if ((rem -= 6656) < 192) { t.task = 1; t.K = 512; t.dst = WT_UQ; }
    else if ((rem -= 192) < 64) { t.task = 2; t.K = 256; t.dst = WT_UK; }
    else if ((rem -= 64) < 64) { t.task = 3; t.K = 256; t.dst = WT_UV; }
    else if ((rem -= 64) < 1536) { t.task = 4; t.K = 3072; t.dst = WT_P; }
    else if ((rem -= 1536) < 1024) { t.task = 5; t.K = 2048; t.dst = WT_O; }
    else if ((rem -= 1024) < 5632) { t.task = 6; t.K = 2048; t.dst = WT_FAB; }
    else { rem -= 5632; t.task = 7; t.K = DFF; t.dst = WT_FD; }
    const int ktiles = t.K >> 6; t.n0 = (rem / ktiles) * 64; t.k0 = (rem % ktiles) * 64;
    t.srci = t.task == 0 ? 12 : t.task == 1 ? 15 : t.task < 4 ? 16 : t.task == 4 ? 19 + (t.k0 >> 10) : t.task == 5 ? 22 : t.task == 6 ? ((t.n0 & 255) < 128 ? 25 : 26) : 29;
    return t;
}
__device__ __forceinline__ void wconv_units(const int tid, const PT& pt, unsigned char* ws, LAS unsigned char* lds, int l, int first, int stride) {
    bf16_t* wt = (bf16_t*)(ws + WS_WT);
    const int lane = tid & 63, w = __builtin_amdgcn_readfirstlane(tid >> 6);
    LAS unsigned char* wl = lds + w * 8704;
    const float* gq = pt.in(13);
#define WC_LOAD(V, T) do { const float* src_ = pt.in((T).srci); _Pragma("unroll") for (int j = 0; j < 64; ++j) V[j] = wsrc(src_, gq, (T).task, l, (T).n0 + lane, (T).k0 + j); } while (0)
#define WC_STORE(V, T) do { _Pragma("unroll") for (int j = 0; j < 32; ++j) *(LAS unsigned*)(wl + lane * 136 + j * 4) = cvt_pk_bf16(V[2 * j], V[2 * j + 1]); \
        asm volatile("s_waitcnt lgkmcnt(0)" ::: "memory"); \
        _Pragma("unroll") for (int i = 0; i < 4; ++i) { const int n = (lane >> 2) + 16 * i, kq = lane & 3; const LAS unsigned char* p = wl + n * 136 + kq * 32; \
            const u32x2 a0 = *(const LAS u32x2*)p, a1 = *(const LAS u32x2*)(p + 8), a2 = *(const LAS u32x2*)(p + 16), a3 = *(const LAS u32x2*)(p + 24); \
            bf16_t* d = wt + (T).dst + (size_t)((T).n0 + n) * (T).K + (T).k0 + kq * 16; \
            *(u32x4*)d = (u32x4){a0.x, a0.y, a1.x, a1.y}; *(u32x4*)(d + 8) = (u32x4){a2.x, a2.y, a3.x, a3.y}; } \
        asm volatile("s_waitcnt lgkmcnt(0)" ::: "memory"); } while (0)
    for (int u = first + w; u < WC_TILES; u += 2 * stride) {
        const int u2 = u + stride; const bool two = u2 < WC_TILES;
        const WcTile ta = wconv_decode(u), tb = wconv_decode(two ? u2 : u);
        float va[64], vb[64];
        WC_LOAD(va, ta); WC_LOAD(vb, tb);
        WC_STORE(va, ta);
        if (two) WC_STORE(vb, tb);
    }
#undef WC_LOAD
#undef WC_STORE
}

__global__ void __launch_bounds__(512, 2) hse_fwd(Params P) {
    extern __shared__ __attribute__((aligned(16))) unsigned char shm[];
    LAS unsigned char* lds = (LAS unsigned char*)shm;
    const int wave_s = __builtin_amdgcn_readfirstlane(threadIdx.x >> 6);
    const int tid = threadIdx.x;
    const int G = gridDim.x, bid = blockIdx.x;
    volatile LAS unsigned* misc = (volatile LAS unsigned*)(lds + LDS_MISC);
    PT pt; pt.t = (LAS unsigned long long*)(lds + LDS_MISC + 64);
    if (tid < 4) misc[tid] = 0u;
    if (tid == 0) {
#pragma unroll
        for (int i = 0; i < 32; ++i) pt.t[i] = (unsigned long long)P.in[i];
        pt.t[32] = (unsigned long long)P.out; pt.t[33] = (unsigned long long)P.ws;
    }
    __syncthreads();
    const int lo = P.ph_lo, hi_all = P.ph_hi;
    XcdBarrier bar; bar.bar = (unsigned*)(P.ws + WS_CTL); bar.x = 0; bar.st = misc;
    if (hi_all - lo > 1) bar = xcd_barrier_post((unsigned*)(P.ws + WS_CTL), misc);
    { const int hi = hi_all;
    int ph = 0;
#define PH_BEGIN(k) if (lo <= ph && ph < hi) { __syncthreads(); const int tid = opaque_tid(wave_s); const int lane = tid & 63; const int wave = __builtin_amdgcn_readfirstlane(tid >> 6); (void)lane; (void)wave; unsigned char* const ws = (unsigned char*)pt.in(33); float* const out = (float*)pt.in(32); (void)out;
#define PH_END   if (ph + 1 < hi) { bar.bar = (unsigned*)((unsigned char*)pt.in(33) + WS_CTL); xcd_barrier(bar, opaque_tid(wave_s)); } } ++ph;
#define INP(k) pt.in(k)
#define ada    ((float*)(ws + WS_ADA))
#define rope   ((float*)(ws + WS_ROPE))
#define sqv    ((float*)(ws + WS_SQ))
#define wt     ((bf16_t*)(ws + WS_WT))
#define hbuf   ((bf16_t*)(ws + WS_H))
#define xbuf   ((bf16_t*)(ws + WS_XB))
#define proj   ((bf16_t*)(ws + WB_PROJ))
#define gatebuf ((bf16_t*)(ws + WB_GATE))
#define qbuf   ((bf16_t*)(ws + WB_Q))
#define ckva   ((bf16_t*)(ws + WB_CKV))
#define kropa  ((bf16_t*)(ws + WB_KROPE))
#define knope  ((bf16_t*)(ws + WB_KNOPE))
#define vtb    ((bf16_t*)(ws + WB_VT))
#define ocat   ((bf16_t*)(ws + WB_OCAT))
#define merged ((bf16_t*)(ws + WB_MERGED))
#define rets   ((bf16_t*)(ws + WB_RETS))
#define retb   ((bf16_t*)(ws + WB_RETB))
#define ubuf   ((bf16_t*)(ws + WF_U))
#define sidebuf ((bf16_t*)(ws + WF_SIDE))

    PH_BEGIN(0)
    {
        constexpr int NU = 2 * (NADA / 32), SST = 52, SBUF = 256 * SST;
        LAS float* sl = (LAS float*)lds;
        const int fi = lane & 15, fk = lane >> 4, kq = tid & 255, sh = wave >> 2;
        const float* const cP = INP(2); const float* const cS = INP(3);
        for (int u0 = bid; u0 < NU; u0 += 3 * G) {
            const float* wb[3]; int ul[3], un0[3]; bool uok[3];
#pragma unroll
            for (int i = 0; i < 3; ++i) { const int uu = u0 + i * G; uok[i] = uu < NU; const int u = uok[i] ? uu : u0; ul[i] = u / (NADA / 32); un0[i] = (u % (NADA / 32)) * 32; wb[i] = INP(10) + (size_t)ul[i] * DM * NADA + un0[i]; }
            f32x4 acc[3][2][3];
#pragma unroll
            for (int i = 0; i < 3; ++i)
#pragma unroll
                for (int nt = 0; nt < 2; ++nt)
#pragma unroll
                    for (int jt = 0; jt < 3; ++jt) acc[i][nt][jt] = (f32x4){0.f, 0.f, 0.f, 0.f};
            const unsigned voffb = (unsigned)((32 * wave + fk) * NADA + fi) * 4u, kqb = (unsigned)kq * 4u;
            float wf[2][3][2][8], cv[18];
#define ADA_LDW(bu, c_) do { unsigned vo_ = voffb; asm volatile("" : "+v"(vo_)); _Pragma("unroll") for (int i_ = 0; i_ < 3; ++i_) _Pragma("unroll") for (int nt_ = 0; nt_ < 2; ++nt_) _Pragma("unroll") for (int ks_ = 0; ks_ < 8; ++ks_) \
                wf[bu][i_][nt_][ks_] = *(const float*)((const char*)(wb[i_] + (size_t)((256 * (c_) + 4 * ks_) * NADA + 16 * nt_)) + vo_); } while (0)
#define ADA_LDC(c_) do { unsigned ko_ = kqb; asm volatile("" : "+v"(ko_)); _Pragma("unroll") for (int q_ = 0; q_ < 18; ++q_) { const int s_ = 18 * sh + q_; const float* cp_ = s_ < NB ? cP + s_ * DM : cS + (s_ - NB) * DM; cv[q_] = *(const float*)((const char*)(cp_ + 256 * (c_)) + ko_); } } while (0)
#define ADA_FILL(bp) do { _Pragma("unroll") for (int q_ = 0; q_ < 18; ++q_) { const float v_ = cv[q_]; (bp)[kq * SST + 18 * sh + q_] = v_ * sigmoidf_(v_); } } while (0)
#define ADA_MM(bu, bp) do { _Pragma("unroll") for (int ks_ = 0; ks_ < 8; ++ks_) { float sf_[3]; _Pragma("unroll") for (int jt_ = 0; jt_ < 3; ++jt_) sf_[jt_] = (bp)[(32 * wave + 4 * ks_ + fk) * SST + 16 * jt_ + fi]; \
                _Pragma("unroll") for (int i_ = 0; i_ < 3; ++i_) _Pragma("unroll") for (int nt_ = 0; nt_ < 2; ++nt_) _Pragma("unroll") for (int jt_ = 0; jt_ < 3; ++jt_) \
                    acc[i_][nt_][jt_] = __builtin_amdgcn_mfma_f32_16x16x4f32(wf[bu][i_][nt_][ks_], sf_[jt_], acc[i_][nt_][jt_], 0, 0, 0); } } while (0)
            __syncthreads();
            for (int z = tid; z < 2 * 256 * 12; z += 512) { const int b = z / (256 * 12), r = z % (256 * 12); sl[b * SBUF + (r / 12) * SST + 36 + (r % 12)] = 0.f; }
            ADA_LDC(0); ADA_LDW(0, 0); ADA_FILL(sl); ADA_LDC(1);
            __syncthreads();
#pragma unroll 1
            for (int c = 0; c < 8; c += 2) {
                ADA_LDW(1, c + 1); ADA_FILL(sl + SBUF); if (c + 2 < 8) ADA_LDC(c + 2);
                ADA_MM(0, sl);
                __syncthreads();
                if (c + 2 < 8) { ADA_LDW(0, c + 2); ADA_FILL(sl); ADA_LDC(c + 3); }
                ADA_MM(1, sl + SBUF);
                __syncthreads();
            }
#undef ADA_LDW
#undef ADA_LDC
#undef ADA_FILL
#undef ADA_MM
            LAS f32x4* red = (LAS f32x4*)lds;
#pragma unroll
            for (int i = 0; i < 3; ++i) {
#pragma unroll
                for (int nt = 0; nt < 2; ++nt)
#pragma unroll
                    for (int jt = 0; jt < 3; ++jt) red[(wave * 6 + nt * 3 + jt) * 64 + lane] = acc[i][nt][jt];
                __syncthreads();
                if (tid < 384 && uok[i]) { const int tile = tid >> 6, ln = tid & 63, nt = tile / 3, jt = tile % 3, s = 16 * jt + (ln & 15), n = un0[i] + 16 * nt + 4 * (ln >> 4);
                    f32x4 v = red[tid];
#pragma unroll
                    for (int w = 1; w < 8; ++w) v += red[w * 384 + tid];
                    if (s < NSTREAM) { v += *(const f32x4*)(INP(11) + ul[i] * NADA + n); *(f32x4*)(ada + ((size_t)ul[i] * NSTREAM + s) * NADA + n) = v; } }
                __syncthreads();
            }
        }
        for (int i = bid * 512 + tid; i < TT * 32; i += G * 512) { const int pos = i >> 5, j = i & 31;
            double inv = 1.0; for (int q = 0; q < j; ++q) inv *= 0.7498942093324559;
            const double t = (double)pos * inv; const double qd = __builtin_rint(t * 0.6366197723675814); const double r = (t - qd * 1.5707963267948966) - qd * 6.123233995736766e-17;
            const double r2 = r * r;
            double sn = r * (1.0 + r2 * (-1.0 / 6 + r2 * (1.0 / 120 + r2 * (-1.0 / 5040 + r2 * (1.0 / 362880 + r2 * (-1.0 / 39916800 + r2 * (1.0 / 6227020800.0)))))));
            double cs = 1.0 + r2 * (-0.5 + r2 * (1.0 / 24 + r2 * (-1.0 / 720 + r2 * (1.0 / 40320 + r2 * (-1.0 / 3628800 + r2 * (1.0 / 479001600.0 + r2 * (-1.0 / 87178291200.0)))))));
            const int qi = (int)((long long)qd & 3); double c2, s2;
            if (qi == 0) { c2 = cs; s2 = sn; } else if (qi == 1) { c2 = -sn; s2 = cs; } else if (qi == 2) { c2 = -cs; s2 = -sn; } else { c2 = sn; s2 = -cs; }
            *(f32x2*)(rope + (size_t)i * 2) = (f32x2){(float)c2, (float)s2}; }
        __syncthreads();
        wconv_units(tid, pt, ws, lds, 0, ((bid + 128) % G) * 8, G * 8);
    }
    PH_END

    PH_BEGIN(1)
    { f32x4 hv[2][2], cv[2][2]; int cst[2] = {-1, -1};
#pragma unroll
      for (int e = 0; e < 2; ++e) { hv[e][0] = (f32x4){0.f, 0.f, 0.f, 0.f}; hv[e][1] = hv[e][0]; cv[e][0] = hv[e][0]; cv[e][1] = hv[e][0]; }
      for (size_t it = (size_t)bid * 512 + tid; it < (size_t)MX * 256; it += (size_t)G * 1024) {
        const size_t it2 = it + (size_t)G * 512; const bool two = it2 < (size_t)MX * 256; const size_t itb = two ? it2 : it;
        f32x4 xv[2][2];
#pragma unroll
        for (int e = 0; e < 2; ++e) { const size_t ii = e ? itb : it; const int ar = (int)(ii >> 8), c = (int)(ii & 255) * 8;
            const float* x = (ar < MP ? INP(0) + (size_t)ar * DM : INP(1) + (size_t)(ar - MP) * DM) + c;
            xv[e][0] = *(const f32x4*)x; xv[e][1] = *(const f32x4*)(x + 4);
            const int st = row_stream(ar);
            if (st != cst[e]) { cst[e] = st; const float* a = ada + (size_t)st * NADA + c; hv[e][0] = *(const f32x4*)a; hv[e][1] = *(const f32x4*)(a + 4); cv[e][0] = *(const f32x4*)(a + DM); cv[e][1] = *(const f32x4*)(a + DM + 4); } }
#pragma unroll
        for (int e = 0; e < 2; ++e) { if (e == 1 && !two) break; const size_t ii = e ? itb : it; const int ar = (int)(ii >> 8), c = (int)(ii & 255) * 8;
            const f32x4 y0 = xv[e][0] * (cv[e][0] + 1.0f) + hv[e][0], y1 = xv[e][1] * (cv[e][1] + 1.0f) + hv[e][1];
            u32x4 w; w.x = cvt_pk_bf16(y0[0], y0[1]); w.y = cvt_pk_bf16(y0[2], y0[3]); w.z = cvt_pk_bf16(y1[0], y1[1]); w.w = cvt_pk_bf16(y1[2], y1[3]);
            *(u32x4*)(hbuf + (size_t)ar * DM + c) = w; } } }
    PH_END

#pragma unroll 1
    for (int l = 0; l < 2; ++l) {
#define adal (ada + (size_t)l * NSTREAM * NADA)
#pragma unroll 1
        for (int g = 0; g < NG; ++g) {
            const Grp gr = make_grp(g);
            PH_BEGIN(2)
            { pg8::Gemm gm{hbuf + (size_t)gr.xr0 * DM, wt + WT_IN, gr.nxr, NPROJ_ALL, 2048, 2048, 2048}; pg8::StaticOrder S; S.init(gm.M, gm.N, G, bid);
              EpiProj E{proj, gatebuf}; pg8::gemm_phase<EpiProj>(tid, lds, gm, S, E); }
            PH_END

            PH_BEGIN(3)
            { const int njobs = gr.nxr;
              const f32x4 gk = *(const f32x4*)(INP(14) + l * 256 + lane * 4);
              struct RowIn { u32x4 wcq; u32x2 wkv; unsigned wkr; f32x2 csr; u32x4 ba[2], bb[2]; f32x4 t0, t1; u32x4 wq, wk; };
              auto row_load = [&](const int job) __attribute__((always_inline)) -> RowIn { RowIn R;
                    const int rr = job, ar = gr.xr0 + rr, pos = row_pos(ar); const bf16_t* pr = proj + (size_t)rr * NPROJ;
                    const bool isp = ar < MP; const bool bandc = !isp || (ar & (TT - 1)) >= TT - 512;
                    R.wcq = *(const u32x4*)(pr + PC_CQ + lane * 8);
                    R.wkv = *(const u32x2*)(pr + PC_CKV + lane * 4);
                    R.wkr = 0u; R.csr = (f32x2){1.f, 0.f};
                    if (lane < 32) { R.wkr = *(const unsigned*)(pr + PC_KR + 2 * lane); R.csr = *(const f32x2*)(rope + ((size_t)pos * 32 + lane) * 2); }
#pragma unroll
                    for (int i = 0; i < 2; ++i) { R.ba[i] = (u32x4){0u, 0u, 0u, 0u}; R.bb[i] = R.ba[i]; }
                    if (bandc) {
#pragma unroll
                        for (int i = 0; i < 2; ++i) { R.ba[i] = *(const u32x4*)(pr + PC_KB + i * 512 + lane * 8); R.bb[i] = *(const u32x4*)(pr + PC_VB + i * 512 + lane * 8); } }
                    const int j0 = (lane & 7) * 4;
                    const float* tp = rope + ((size_t)pos * 32 + j0) * 2; R.t0 = *(const f32x4*)tp; R.t1 = *(const f32x4*)(tp + 4);
                    R.wq = *(const u32x4*)(pr + PC_QR + lane * 8); R.wk = *(const u32x4*)(pr + PC_KRR + lane * 8);
                    return R; };
              auto row_finish = [&](const int job, RowIn& R) __attribute__((always_inline)) {
                    const int rr = job, ar = gr.xr0 + rr, pos = row_pos(ar), kvr = row_kv(ar) - gr.kv0; bf16_t* pr = proj + (size_t)rr * NPROJ;
                    const bool isp = ar < MP; const bool bandc = !isp || (ar & (TT - 1)) >= TT - 512; const int hh = lane >> 3;
                    { const u32x4 w = R.wcq; float ss = bf_lo(w.x) * bf_lo(w.x) + bf_hi(w.x) * bf_hi(w.x) + bf_lo(w.y) * bf_lo(w.y) + bf_hi(w.y) * bf_hi(w.y)
                          + bf_lo(w.z) * bf_lo(w.z) + bf_hi(w.z) * bf_hi(w.z) + bf_lo(w.w) * bf_lo(w.w) + bf_hi(w.w) * bf_hi(w.w);
                      ss = wave_sum(ss); if (lane == 0) sqv[ar] = rsqrtf(ss * (1.0f / 512.0f) + EPS); }
                    { const u32x2 w = R.wkv; const float x0 = bf_lo(w.x), x1 = bf_hi(w.x), x2 = bf_lo(w.y), x3 = bf_hi(w.y);
                      float ss = wave_sum(x0 * x0 + x1 * x1 + x2 * x2 + x3 * x3); const float rs = rsqrtf(ss * (1.0f / 256.0f) + EPS);
                      const f32x4 y = {x0 * rs * gk[0], x1 * rs * gk[1], x2 * rs * gk[2], x3 * rs * gk[3]};
                      float* o = isp ? out + O_CKV_P + ((size_t)l * MP + ar) * 256 : out + O_CKV_S + ((size_t)l * MS + (ar - MP)) * 256; *(f32x4*)(o + lane * 4) = y;
                      *(u32x2*)(ckva + (size_t)kvr * 256 + lane * 4) = (u32x2){cvt_pk_bf16(y[0], y[1]), cvt_pk_bf16(y[2], y[3])}; }
                    if (lane < 32) { const float x1 = bf_lo(R.wkr), x2 = bf_hi(R.wkr);
                      const float o1 = x1 * R.csr.x - x2 * R.csr.y, o2 = x2 * R.csr.x + x1 * R.csr.y;
                      float* o = isp ? out + O_KR_P + ((size_t)l * MP + ar) * 64 : out + O_KR_S + ((size_t)l * MS + (ar - MP)) * 64; o[lane] = o1; o[32 + lane] = o2;
                      *(unsigned*)(kropa + (size_t)kvr * 64 + 2 * lane) = cvt_pk_bf16(o1, o2); }
                    if (bandc) { float* ok; float* ov;
                      if (!isp) { ok = out + O_BK_S + ((size_t)l * MS + (ar - MP)) * 1024; ov = out + O_BV_S + ((size_t)l * MS + (ar - MP)) * 1024; }
                      else { const size_t idx = (((size_t)l * NB + (ar >> 13)) * 512 + ((ar & (TT - 1)) - (TT - 512))) * 1024; ok = out + O_BK_P + idx; ov = out + O_BV_P + idx; }
#pragma unroll
                      for (int i = 0; i < 2; ++i) { const u32x4 a = R.ba[i], b = R.bb[i];
                          *(f32x4*)(ok + i * 512 + lane * 8) = (f32x4){bf_lo(a.x), bf_hi(a.x), bf_lo(a.y), bf_hi(a.y)}; *(f32x4*)(ok + i * 512 + lane * 8 + 4) = (f32x4){bf_lo(a.z), bf_hi(a.z), bf_lo(a.w), bf_hi(a.w)};
                          *(f32x4*)(ov + i * 512 + lane * 8) = (f32x4){bf_lo(b.x), bf_hi(b.x), bf_lo(b.y), bf_hi(b.y)}; *(f32x4*)(ov + i * 512 + lane * 8 + 4) = (f32x4){bf_lo(b.z), bf_hi(b.z), bf_lo(b.w), bf_hi(b.w)}; } }
                    { const float lg = lg2_gamma(hh); const int ic = isp ? (pos & 63) : (pos - PAST); const int L = isp ? 64 : ST;
                      const float qs = __builtin_amdgcn_exp2f((float)(ic + 1) * lg - 3.0f), ks = __builtin_amdgcn_exp2f((float)(L - 1 - ic) * lg);
                      const f32x4 t0 = R.t0, t1 = R.t1; u32x4 wq = R.wq, wk = R.wk;
#define ROT(W, C, S_, SC) cvt_pk_bf16((bf_lo(W) * (C) - bf_hi(W) * (S_)) * (SC), (bf_hi(W) * (C) + bf_lo(W) * (S_)) * (SC))
                      wq.x = ROT(wq.x, t0[0], t0[1], qs); wq.y = ROT(wq.y, t0[2], t0[3], qs); wq.z = ROT(wq.z, t1[0], t1[1], qs); wq.w = ROT(wq.w, t1[2], t1[3], qs);
                      wk.x = ROT(wk.x, t0[0], t0[1], ks); wk.y = ROT(wk.y, t0[2], t0[3], ks); wk.z = ROT(wk.z, t1[0], t1[1], ks); wk.w = ROT(wk.w, t1[2], t1[3], ks);
#undef ROT
                      *(u32x4*)(pr + PC_QR + lane * 8) = wq; *(u32x4*)(pr + PC_KRR + lane * 8) = wk; } };
              for (int job = bid * 8 + wave; job < njobs; job += G * 16) {
                  const int job2 = job + G * 8; const bool two = job2 < njobs;
                  RowIn RA = row_load(job); RowIn RB = row_load(two ? job2 : job);
                  row_finish(job, RA); if (two) row_finish(job2, RB);
              }
              if (gr.samp) { const int ncj = SB * PAST;
                for (int cj0 = bid * 8 + wave; cj0 < ncj; cj0 += G * 32) {
                    f32x4 cvv[4]; float k0v[4], k1v[4];
#pragma unroll
                    for (int e = 0; e < 4; ++e) { const int cjj = cj0 + e * G * 8; const int cj = cjj < ncj ? cjj : cj0; const int b = cj >> 10, t = cj & 1023;
                        cvv[e] = *(const f32x4*)(INP(4) + (((size_t)l * SB + b) * PAST + t) * 256 + lane * 4);
                        const float* ks = INP(5) + (((size_t)l * SB + b) * PAST + t) * 64; k0v[e] = ks[lane & 31]; k1v[e] = ks[32 + (lane & 31)]; }
#pragma unroll
                    for (int e = 0; e < 4; ++e) { const int cj = cj0 + e * G * 8; if (cj < ncj) { const int b = cj >> 10, t = cj & 1023; const int kvr = MP + b * KVS + t - gr.kv0;
                        *(u32x2*)(ckva + (size_t)kvr * 256 + lane * 4) = (u32x2){cvt_pk_bf16(cvv[e][0], cvv[e][1]), cvt_pk_bf16(cvv[e][2], cvv[e][3])};
                        if (lane < 32) *(unsigned*)(kropa + (size_t)kvr * 64 + 2 * lane) = cvt_pk_bf16(k0v[e], k1v[e]); } }
                } } }
            PH_END

            PH_BEGIN(4)
            {
              { const int tid = opaque_tid(wave_s); pg8::Gemm gm{proj + PC_CQ, wt + WT_UQ, gr.nxr, 1536, 512, NPROJ, 512}; pg8::StaticOrder S; S.init(gm.M, gm.N, G, bid);
                EpiQ E{qbuf, sqv, rope, gr.xr0}; pg8::gemm_phase<EpiQ>(tid, lds, gm, S, E); }
              { const int tid = opaque_tid(wave_s); pg8::Gemm gm{ckva, wt + WT_UK, gr.nkv, 1024, 256, 256, 256}; pg8::StaticOrder S; S.init(gm.M, gm.N, G, (bid + 136) % G);
                EpiPlain<1024> E{knope}; pg8::gemm_phase<EpiPlain<1024>>(tid, lds, gm, S, E); }
              { const int tid = opaque_tid(wave_s); pg8::Gemm gm{wt + WT_UV, ckva, 1024, gr.nkv, 256, 256, 256}; pg8::StaticOrder S; S.init(gm.M, gm.N, G, (bid + 72) % G);
                EpiPlain<VT_LD> E{vtb}; pg8::gemm_phase<EpiPlain<VT_LD>>(tid, lds, gm, S, E); }
              __syncthreads();
              { const int tid = opaque_tid(wave_s); const int lane = tid & 63; const int nun = GNB * 8 * 128;
                  const int uqu = (gr.nxr / 256) * 6, nl = uqu - G, nh = G - nl; const bool bal = nl > 0 && nh > 0 && 6 * G <= nun;
#define RET_UNIT(k) (!bal ? (((bid + 200) % G + (k) * G) < nun ? ((bid + 200) % G + (k) * G) : -1) : ((k) < 6 ? bid + G * (k) : (bid < nl ? -1 : ((6 * G + (bid - nl) + nh * ((k) - 6)) < nun ? (6 * G + (bid - nl) + nh * ((k) - 6)) : -1))))
                  int k = 0; int u = RET_UNIT(0); int buf = 0; RetRegs R = ret_fetch(tid, proj, 0, 0, false);
                  if (u >= 0) R = ret_fetch(tid, proj + (size_t)((u >> 10) * TT + (u & 127) * 64) * NPROJ, 64, (u >> 7) & 7, false);
                  while (u >= 0) { LAS unsigned char* lb = lds + buf * RT_BUF;
                      ret_put(tid, lb, R, false);
                      __syncthreads();
                      const int un = RET_UNIT(k + 1); if (un >= 0) R = ret_fetch(tid, proj + (size_t)((un >> 10) * TT + (un & 127) * 64) * NPROJ, 64, (un >> 7) & 7, false);
                      const int eb = wave & 3, dbk = wave >> 2; const f32x16 acc = ret_state(tid, lb, eb, dbk);
                      bf16_t* dst = rets + (size_t)u * 8192 + (32 * dbk + (lane & 31));
#pragma unroll
                      for (int r = 0; r < 16; r += 2) {
                          const bool odd = lane & 1; const float mine = odd ? acc[r + 1] : acc[r], send = odd ? acc[r] : acc[r + 1];
                          const float recv = __int_as_float(__builtin_amdgcn_mov_dpp(__float_as_int(send), 0xB1, 0xF, 0xF, false));
                          const unsigned w = odd ? cvt_pk_bf16(recv, mine) : cvt_pk_bf16(mine, recv);
                          const int rq = odd ? r + 1 : r;
                          *(unsigned*)(dst - (lane & 1) + (size_t)(32 * eb + (rq & 3) + 8 * (rq >> 2) + 4 * (lane >> 5)) * 64) = w; }
                      buf ^= 1; u = un; ++k; }
#undef RET_UNIT
              } }
            PH_END

            PH_BEGIN(5)
            { const int n_mla = GNB * 8 * 16, n_band = GNB * 8 * 32, n_scan = GNB * 8 * 16, n_smp = gr.samp ? SB * 8 : 0;
              const int n_items = n_mla + n_band + n_scan + 2 * n_smp;
              const int bx = ((G & 7) == 0 && n_mla % G == 0 && n_band % G == 0) ? (bid & 7) * (G >> 3) + (bid >> 3) : bid;
              const int l31 = lane & 31;
              for (int it = bid; it < n_items; it += G) {
                if (it < n_mla) {
                    const int itx = it - bid + bx;
                    const int x = itx & 15, h = (itx >> 4) & 7, bl = itx >> 7;
                    MlaLoader L; L.tid = tid; L.kn = (const char*)(knope + (size_t)(bl * TT) * 1024 + h * 128); L.kr = (const char*)(kropa + (size_t)(bl * TT) * 64); L.vt = (const char*)(vtb + (size_t)(h * 128) * VT_LD + bl * TT); L.nkeys = TT;
#pragma unroll 1
                    for (int pass = 0; pass < 2; ++pass) { const int qb = (pass & 1) == 0 ? x : 31 - x; const int rr = bl * TT + qb * 256 + wave * 32 + l31; const int cw = 4 * qb + (wave >> 1);
                        attn_unit<192, false, MlaLoader>(tid, lds, L, qbuf + (size_t)rr * 1536 + h * 192, true, 0, 4 * qb + 4, 0, cw + 1, TT, 0, 0, ocat + (size_t)rr * 3072 + h * 128); }
                } else if (it < n_mla + n_band) {
                    const int u = it - n_mla - bid + bx, qb = u & 31, h = (u >> 5) & 7, bl = u >> 8;
                    __syncthreads();
                    { LAS float* bt = (LAS float*)(lds + AT_BIAS); if (tid < 257) bt[tid] = INP(17)[((size_t)l * 8 + h) * 257 + tid] * LOG2E; }
                    BandLoader L; L.tid = tid; L.kc = nullptr; L.vc = nullptr; L.ncache = 0; L.kp = (const char*)(proj + (size_t)(bl * TT) * NPROJ + PC_KB + h * 128); L.vp = (const char*)(proj + (size_t)(bl * TT) * NPROJ + PC_VB + h * 128); L.nkeys = TT;
                    const int rr = bl * TT + qb * 256 + wave * 32 + l31; const int cw = 4 * qb + (wave >> 1); const int t0 = (4 * qb - 8) > 0 ? (4 * qb - 8) : 0, wt0 = (cw - 8) > 0 ? (cw - 8) : 0;
                    attn_unit<128, true, BandLoader>(tid, lds, L, proj + (size_t)rr * NPROJ + PC_QB + h * 128, true, t0, 4 * qb + 4, wt0, cw + 1, TT, qb * 256 + wave * 32 + l31, 0, ocat + (size_t)rr * 3072 + 1024 + h * 128);
                } else if (it < n_mla + n_band + n_scan) {
                    const int u = it - n_mla - n_band, sl = u & 15, h = (u >> 4) & 7, bl = u >> 7; const int idx = sl * 512 + tid;
                    const bf16_t* p = rets + (size_t)((bl * 8 + h) * 128) * 8192 + idx; bf16_t* pb = retb + (size_t)((bl * 8 + h) * 128) * 8192 + idx; const float g64 = __builtin_amdgcn_exp2f(64.0f * lg2_gamma(h)); float run = 0.f;
                    float v[32];
#pragma unroll
                    for (int j = 0; j < 32; ++j) v[j] = __uint_as_float((unsigned)p[(size_t)j * 8192] << 16);
#pragma unroll 1
                    for (int c = 0; c < 128; c += 32) { float vn[32]; const int cn = c + 32 < 128 ? c + 32 : c;
#pragma unroll
                        for (int j = 0; j < 32; ++j) vn[j] = __uint_as_float((unsigned)p[(size_t)(cn + j) * 8192] << 16);
#pragma unroll
                        for (int j = 0; j < 32; j += 2) {
                            const float r0 = run; run = g64 * run + v[j]; const float r1 = run; run = g64 * run + v[j + 1];
                            const bool odd = lane & 1; const float mine = odd ? r1 : r0, send = odd ? r0 : r1;
                            const float recv = __int_as_float(__builtin_amdgcn_mov_dpp(__float_as_int(send), 0xB1, 0xF, 0xF, false));
                            const unsigned w = odd ? cvt_pk_bf16(recv, mine) : cvt_pk_bf16(mine, recv);
                            *(unsigned*)(pb - (lane & 1) + (size_t)(c + j + (odd ? 1 : 0)) * 8192) = w; }
#pragma unroll
                        for (int j = 0; j < 32; ++j) v[j] = vn[j]; }
                    const int e = idx >> 6, d = idx & 63;
                    out[O_RET_P + ((((size_t)l * NB + gr.b0 + bl) * 8 + h) * 64 + ((d & 1) * 32 + (d >> 1))) * 128 + e] = run;
                } else if (it < n_mla + n_band + n_scan + n_smp) {
                    const int u = it - n_mla - n_band - n_scan, h = u & 7, b = u >> 3;
                    const int kvb = MP + b * KVS - gr.kv0; MlaLoader L; L.tid = tid; L.kn = (const char*)(knope + (size_t)kvb * 1024 + h * 128); L.kr = (const char*)(kropa + (size_t)kvb * 64); L.vt = (const char*)(vtb + (size_t)(h * 128) * VT_LD + kvb); L.nkeys = KVS;
                    const int qi = l31 < 16 ? l31 : 15; const int rr = MP + b * ST + qi - gr.xr0;
                    attn_unit<192, false, MlaLoader>(tid, lds, L, qbuf + (size_t)rr * 1536 + h * 192, wave == 0, 0, 17, 0, 17, KVS, 0, 0, (wave == 0 && l31 < 16) ? ocat + (size_t)rr * 3072 + h * 128 : nullptr);
                } else {
                    const int u = it - n_mla - n_band - n_scan - n_smp, h = u & 7, b = u >> 3;
                    __syncthreads();
                    { LAS float* bt = (LAS float*)(lds + AT_BIAS); if (tid < 257) bt[tid] = INP(17)[((size_t)l * 8 + h) * 257 + tid] * LOG2E; }
                    const int r0 = MP + b * ST - gr.xr0;
                    BandLoader L; L.tid = tid; L.kc = (const char*)(INP(6) + (((size_t)l * SB + b) * 512) * 1024 + h * 128); L.vc = (const char*)(INP(7) + (((size_t)l * SB + b) * 512) * 1024 + h * 128); L.ncache = 512;
                    L.kp = (const char*)(proj + (size_t)r0 * NPROJ + PC_KB + h * 128); L.vp = (const char*)(proj + (size_t)r0 * NPROJ + PC_VB + h * 128); L.nkeys = 528;
                    const int qi = l31 < 16 ? l31 : 15; const int rr = r0 + qi;
                    attn_unit<128, true, BandLoader>(tid, lds, L, proj + (size_t)rr * NPROJ + PC_QB + h * 128, wave == 0, 0, 9, 0, 9, 528, PAST + qi, 512, (wave == 0 && l31 < 16) ? ocat + (size_t)rr * 3072 + 1024 + h * 128 : nullptr);
                }
              } }
            PH_END

            PH_BEGIN(6)
            { const int n_p = GNB * 8 * 128, n_s = gr.samp ? SB * 8 : 0;
              const int eb = wave & 3, qbk = wave >> 2, l31 = lane & 31;
              { int it = bid; int buf = 0; RetRegs R = ret_fetch(tid, proj, 0, 0, false);
                const unsigned spo = (unsigned)((32 * eb + l31) * 64 + 8 * (lane >> 5)) * 2u;
                u32x4 sr[4];
                { const char* sp = (const char*)(retb + (size_t)(it < n_p ? it : 0) * 8192) + spo;
#pragma unroll
                  for (int ks = 0; ks < 4; ++ks) sr[ks] = *(const u32x4*)(sp + 32 * ks); }
                if (it < n_p) R = ret_fetch(tid, proj + (size_t)((it >> 10) * TT + (it & 127) * 64) * NPROJ, 64, (it >> 7) & 7, true);
                for (; it < n_p; it += G) { const int c = it & 127, h = (it >> 7) & 7, bl = it >> 10; const int r0 = bl * TT + c * 64; LAS unsigned char* lb = lds + buf * RT_BUF;
                    ret_put(tid, lb, R, true);
                    __syncthreads();
                    const int un = it + G;
                    if (un < n_p) R = ret_fetch(tid, proj + (size_t)((un >> 10) * TT + (un & 127) * 64) * NPROJ, 64, (un >> 7) & 7, true);
                    const float ginvL = __builtin_amdgcn_exp2f(-64.0f * lg2_gamma(h));
                    bf16x8 sf[4];
#pragma unroll
                    for (int ks = 0; ks < 4; ++ks) { u32x4 w = sr[ks]; sf[ks] = *reinterpret_cast<bf16x8*>(&w); }
                    { const char* sp = (const char*)(retb + (size_t)(un < n_p ? un : it) * 8192) + spo;
#pragma unroll
                      for (int ks = 0; ks < 4; ++ks) sr[ks] = *(const u32x4*)(sp + 32 * ks); }
                    const int rr = r0 + 32 * qbk + l31;
                    const RetGate RG = ret_gate_load(INP(18) + l * 1024 + h * 128, proj + (size_t)rr * NPROJ + PC_GR + h * 128, true, eb, tid);
                    const f32x16 acc = ret_out(tid, lb, eb, qbk, ginvL, sf);
                    ret_finish(lb, acc, eb, qbk, RG, ocat + (size_t)rr * 3072 + 2048 + h * 128, tid);
                    buf ^= 1; }
                __syncthreads(); }
              for (int it = n_p + bid; it < n_p + n_s; it += G) {
                {
                  const int u = it - n_p, h = u & 7, b = u >> 3; const int r0 = MP + b * ST - gr.xr0;
                    ret_load(tid, lds, proj + (size_t)r0 * NPROJ, ST, h, true);
                    __syncthreads();
                    const float* sp = INP(8) + (((size_t)l * SB + b) * 8 + h) * 8192;
                    const float lg = lg2_gamma(h); const float ginvL = __builtin_amdgcn_exp2f(-16.0f * lg), g16 = __builtin_amdgcn_exp2f(16.0f * lg);
                    { const f32x16 kc = ret_state(tid, lds, wave & 3, wave >> 2); const int d = 32 * (wave >> 2) + l31; float* o = out + O_RET_S + (((size_t)l * SB + b) * 8 + h) * 8192;
#pragma unroll
                      for (int r = 0; r < 16; ++r) { const int e = 32 * (wave & 3) + (r & 3) + 8 * (r >> 2) + 4 * (lane >> 5); const int dor = (d & 1) * 32 + (d >> 1); o[dor * 128 + e] = g16 * sp[dor * 128 + e] + kc[r]; } }
                    bf16x8 sf[4];
#pragma unroll
                    for (int ks = 0; ks < 4; ++ks) { float v[8]; const int e = 32 * eb + l31, d0 = 16 * ks + 8 * (lane >> 5);
#pragma unroll
                        for (int j = 0; j < 8; ++j) v[j] = sp[(((d0 + j) & 1) * 32 + ((d0 + j) >> 1)) * 128 + e];
                        u32x4 w = {cvt_pk_bf16(v[0], v[1]), cvt_pk_bf16(v[2], v[3]), cvt_pk_bf16(v[4], v[5]), cvt_pk_bf16(v[6], v[7])}; sf[ks] = *reinterpret_cast<bf16x8*>(&w); }
                    const f32x16 acc = ret_out(tid, lds, eb, qbk, ginvL, sf);
                    const bool ok = (qbk == 0 && l31 < ST); const int rr = r0 + (ok ? l31 : 0);
                    { const RetGate RG = ret_gate_load(INP(18) + l * 1024 + h * 128, proj + (size_t)rr * NPROJ + PC_GR + h * 128, ok, eb, tid);
                      ret_finish(lds, acc, eb, qbk, RG, ok ? ocat + (size_t)rr * 3072 + 2048 + h * 128 : nullptr, tid); }
                    __syncthreads();
                }
              } }
            PH_END

            PH_BEGIN(7)
            { pg8::Gemm gm{ocat, wt + WT_P, GPR, 2048, 3072, 3072, 3072}; pg8::StaticOrder S; S.init(gm.M, gm.N, G, bid);
              EpiMerge E{merged, gatebuf}; pg8::gemm_phase<EpiMerge>(tid, lds, gm, S, E); }
            if (gr.samp) { const int tid = opaque_tid(wave_s); const int w = __builtin_amdgcn_readfirstlane(tid >> 6);
              const int br = w < 3 ? 0 : (w < 6 ? 1 : 2), wi = w - 3 * br; const int kch0 = br < 2 ? 16 * br + (wi == 0 ? 0 : (wi == 1 ? 6 : 11)) : 32 + 8 * wi, nc = br < 2 ? (wi == 0 ? 6 : 5) : 8;
              skinny_tiles(tid, lds, ocat + (size_t)GPR * 3072, 3072, wt + WT_P, 3072, kch0, nc, G, bid, SkMergePre{gatebuf, br}, SkMergeFin{merged}); }
            PH_END

            PH_BEGIN(8)
            { pg8::Gemm gm{merged, wt + WT_O, GPR, 2048, 2048, 2048, 2048}; pg8::StaticOrder S; S.init(gm.M, gm.N, G, bid);
              EpiGate E{hbuf, adal + 2 * DM, gr.xr0}; pg8::gemm_phase<EpiGate>(tid, lds, gm, S, E); }
            if (gr.samp) { const int tid = opaque_tid(wave_s); const int w = __builtin_amdgcn_readfirstlane(tid >> 6);
              skinny_tiles(tid, lds, merged + (size_t)GPR * 2048, 2048, wt + WT_O, 2048, w * 4, 4, G, bid, SkNoPre{}, SkGateFin{hbuf, adal + 2 * DM}); }
            PH_END
        }

        PH_BEGIN(9)
        { f32x4 gg[8], bb[8];
#pragma unroll
        for (int i = 0; i < 8; ++i) { const int c = i * 256 + lane * 4; gg[i] = *(const f32x4*)(INP(23) + l * DM + c); bb[i] = *(const f32x4*)(INP(24) + l * DM + c); }
        f32x4 sh[8], sc[8]; int cst = -1;
#pragma unroll
        for (int i = 0; i < 8; ++i) { sh[i] = gg[i]; sc[i] = gg[i]; }
        for (int ar = bid * 8 + wave; ar < MX; ar += G * 8) { bf16_t* xr = xbuf + (size_t)ar * DM; f32x4 v[8]; float s = 0.f;
            const float* xs = ar < MP ? INP(0) + (size_t)ar * DM : INP(1) + (size_t)(ar - MP) * DM; const bf16_t* vb = hbuf + (size_t)ar * DM; const int st = row_stream(ar); const float* a = adal + (size_t)st * NADA;
#pragma unroll
            for (int i = 0; i < 8; ++i) { f32x4 x; if (l == 0) x = *(const f32x4*)(xs + i * 256 + lane * 4); else { const u32x2 xw = *(const u32x2*)(xr + i * 256 + lane * 4); x = (f32x4){bf_lo(xw.x), bf_hi(xw.x), bf_lo(xw.y), bf_hi(xw.y)}; }
                const u32x2 w = *(const u32x2*)(vb + i * 256 + lane * 4);
                v[i] = x * ALPHA + (f32x4){bf_lo(w.x), bf_hi(w.x), bf_lo(w.y), bf_hi(w.y)}; s += (v[i][0] + v[i][1]) + (v[i][2] + v[i][3]); }
            if (st != cst) { cst = st;
#pragma unroll
                for (int i = 0; i < 8; ++i) { const int c = i * 256 + lane * 4; sh[i] = *(const f32x4*)(a + 3 * DM + c); sc[i] = *(const f32x4*)(a + 4 * DM + c); } }
            const float mean = wave_sum(s) * (1.0f / DM); float q = 0.f;
#pragma unroll
            for (int i = 0; i < 8; ++i) { const f32x4 d = v[i] - mean; q += (d[0] * d[0] + d[1] * d[1]) + (d[2] * d[2] + d[3] * d[3]); }
            const float rstd = rsqrtf(wave_sum(q) * (1.0f / DM) + EPS);
#pragma unroll
            for (int i = 0; i < 8; ++i) { const int c = i * 256 + lane * 4;
                const f32x4 y = (v[i] - mean) * rstd * gg[i] + bb[i]; *(u32x2*)(xr + c) = (u32x2){cvt_pk_bf16(y[0], y[1]), cvt_pk_bf16(y[2], y[3])};
                const f32x4 hh = y * (sc[i] + 1.0f) + sh[i];
                *(u32x2*)(hbuf + (size_t)ar * DM + c) = (u32x2){cvt_pk_bf16(hh[0], hh[1]), cvt_pk_bf16(hh[2], hh[3])}; } } }
        PH_END

        PH_BEGIN(10)
        { pg8::Gemm gm{hbuf, wt + WT_FAB, MX, NFAB, 2048, 2048, 2048}; pg8::StaticOrder S; S.init(gm.M, gm.N, G, bid);
          EpiConv E{ubuf, sidebuf, INP(27) + (size_t)l * 3 * DFF, INP(28) + (size_t)l * DFF}; pg8::gemm_phase<EpiConv>(tid, lds, gm, S, E); }
        PH_END

        PH_BEGIN(11)
        { const int ngrp = MP / 64 + MS / 16;
          for (int it = bid * 512 + tid; it < ngrp * (DFF / 8); it += G * 512) { const int gq = it / (DFF / 8), c = (it % (DFF / 8)) * 8;
            const bool isp = gq < MP / 64; const int r0 = isp ? gq * 64 : MP + (gq - MP / 64) * 16; const int gi = r0 >> 4;
            const bool seqstart = isp ? ((r0 & (TT - 1)) == 0) : true;
            float am2[8], am1[8], a0[8], a1[8], b0[8], b1[8];
#define LD8(dst, p) { const u32x4 w_ = *(const u32x4*)(p); dst[0] = bf_lo(w_.x); dst[1] = bf_hi(w_.x); dst[2] = bf_lo(w_.y); dst[3] = bf_hi(w_.y); dst[4] = bf_lo(w_.z); dst[5] = bf_hi(w_.z); dst[6] = bf_lo(w_.w); dst[7] = bf_hi(w_.w); }
            if (seqstart) { if (isp) {
#pragma unroll
                    for (int j = 0; j < 8; ++j) { am2[j] = 0.f; am1[j] = 0.f; } }
                else { const float* sc = INP(9) + (((size_t)l * SB + ((r0 - MP) >> 4)) * 2) * DFF + c;
#pragma unroll
                    for (int j = 0; j < 8; ++j) { am2[j] = sc[j]; am1[j] = sc[DFF + j]; } } }
            else { const bf16_t* pp = sidebuf + (size_t)(gi - 1) * 6 * DFF + c; LD8(am2, pp + 4 * DFF); LD8(am1, pp + 5 * DFF); }
            const bf16_t* sp = sidebuf + (size_t)gi * 6 * DFF + c; LD8(a0, sp); LD8(a1, sp + DFF); LD8(b0, sp + 2 * DFF); LD8(b1, sp + 3 * DFF);
            f32x4 w0v[2], w1v[2], w2v[2], cbq[2];
#pragma unroll
            for (int q = 0; q < 2; ++q) { w0v[q] = *(const f32x4*)(INP(27) + ((size_t)l * 3 + 0) * DFF + c + 4 * q); w1v[q] = *(const f32x4*)(INP(27) + ((size_t)l * 3 + 1) * DFF + c + 4 * q);
                w2v[q] = *(const f32x4*)(INP(27) + ((size_t)l * 3 + 2) * DFF + c + 4 * q); cbq[q] = *(const f32x4*)(INP(28) + (size_t)l * DFF + c + 4 * q); }
            float u0[8], u1[8];
#pragma unroll
            for (int j = 0; j < 8; ++j) { const float cw0 = w0v[j >> 2][j & 3], cw1 = w1v[j >> 2][j & 3], cw2 = w2v[j >> 2][j & 3], cbv = cbq[j >> 2][j & 3];
                u0[j] = gelu1(cbv + am2[j] * cw0 + am1[j] * cw1 + a0[j] * cw2) * b0[j]; u1[j] = gelu1(cbv + am1[j] * cw0 + a0[j] * cw1 + a1[j] * cw2) * b1[j]; }
            *(u32x4*)(ubuf + (size_t)r0 * DFF + c) = (u32x4){cvt_pk_bf16(u0[0], u0[1]), cvt_pk_bf16(u0[2], u0[3]), cvt_pk_bf16(u0[4], u0[5]), cvt_pk_bf16(u0[6], u0[7])};
            *(u32x4*)(ubuf + (size_t)(r0 + 1) * DFF + c) = (u32x4){cvt_pk_bf16(u1[0], u1[1]), cvt_pk_bf16(u1[2], u1[3]), cvt_pk_bf16(u1[4], u1[5]), cvt_pk_bf16(u1[6], u1[7])};
            const bool seqend = isp ? (((r0 + 64) & (TT - 1)) == 0) : true;
            if (seqend) { const int gl = isp ? gi + 3 : gi; const bf16_t* lp = sidebuf + (size_t)gl * 6 * DFF + c; float e0[8], e1[8]; LD8(e0, lp + 4 * DFF); LD8(e1, lp + 5 * DFF);
                float* o = isp ? out + O_CONV_P + (((size_t)l * NB + (r0 >> 13)) * 2) * DFF + c : out + O_CONV_S + (((size_t)l * SB + ((r0 - MP) >> 4)) * 2) * DFF + c;
#pragma unroll
                for (int j = 0; j < 8; ++j) { o[j] = e0[j]; o[DFF + j] = e1[j]; } }
#undef LD8
          } }
        PH_END

        PH_BEGIN(12)
        { pg8::Gemm gm{ubuf, wt + WT_FD, MP, 2048, DFF, DFF, DFF}; pg8::StaticOrder S; S.init(gm.M, gm.N, G, bid);
          EpiGate E{hbuf, adal + 5 * DM, 0}; pg8::gemm_phase<EpiGate>(tid, lds, gm, S, E); }
        { const int tid = opaque_tid(wave_s); const int w = __builtin_amdgcn_readfirstlane(tid >> 6);
          skinny_tiles(tid, lds, ubuf + (size_t)MP * DFF, DFF, wt + WT_FD, DFF, w * 11, 11, G, bid, SkNoPre{}, SkGateFin{hbuf, adal + 5 * DM}); }
        PH_END

        PH_BEGIN(13)
        { const float* adan = ada + (size_t)NSTREAM * NADA;
          f32x4 gg[8], bb[8];
#pragma unroll
          for (int i = 0; i < 8; ++i) { const int c = i * 256 + lane * 4; gg[i] = *(const f32x4*)(INP(30) + l * DM + c); bb[i] = *(const f32x4*)(INP(31) + l * DM + c); }
          f32x4 sh[8], sc[8]; int cst = -1;
#pragma unroll
          for (int i = 0; i < 8; ++i) { sh[i] = gg[i]; sc[i] = gg[i]; }
          for (int ar = bid * 8 + wave; ar < MX; ar += G * 8) { bf16_t* xr = xbuf + (size_t)ar * DM; float* yo = out + O_Y + (size_t)ar * DM; f32x4 v[8]; float s = 0.f; const bf16_t* vb = hbuf + (size_t)ar * DM;
            const int st = row_stream(ar); const float* a = adan + (size_t)st * NADA;
#pragma unroll
            for (int i = 0; i < 8; ++i) { const u32x2 xw = *(const u32x2*)(xr + i * 256 + lane * 4), w = *(const u32x2*)(vb + i * 256 + lane * 4);
                v[i] = (f32x4){bf_lo(xw.x), bf_hi(xw.x), bf_lo(xw.y), bf_hi(xw.y)} * ALPHA + (f32x4){bf_lo(w.x), bf_hi(w.x), bf_lo(w.y), bf_hi(w.y)}; s += (v[i][0] + v[i][1]) + (v[i][2] + v[i][3]); }
            if (l == 0 && st != cst) { cst = st;
#pragma unroll
                for (int i = 0; i < 8; ++i) { const int c = i * 256 + lane * 4; sh[i] = *(const f32x4*)(a + c); sc[i] = *(const f32x4*)(a + DM + c); } }
            const float mean = wave_sum(s) * (1.0f / DM); float q = 0.f;
#pragma unroll
            for (int i = 0; i < 8; ++i) { const f32x4 d = v[i] - mean; q += (d[0] * d[0] + d[1] * d[1]) + (d[2] * d[2] + d[3] * d[3]); }
            const float rstd = rsqrtf(wave_sum(q) * (1.0f / DM) + EPS);
#pragma unroll
            for (int i = 0; i < 8; ++i) { const int c = i * 256 + lane * 4;
                const f32x4 y = (v[i] - mean) * rstd * gg[i] + bb[i];
                if (l == 0) { *(u32x2*)(xr + c) = (u32x2){cvt_pk_bf16(y[0], y[1]), cvt_pk_bf16(y[2], y[3])};
                    const f32x4 hh = y * (sc[i] + 1.0f) + sh[i];
                    *(u32x2*)(hbuf + (size_t)ar * DM + c) = (u32x2){cvt_pk_bf16(hh[0], hh[1]), cvt_pk_bf16(hh[2], hh[3])}; }
                else *(f32x4*)(yo + c) = y; } }
          if (l == 0) { __syncthreads(); wconv_units(tid, pt, ws, lds, 1, bid * 8, G * 8); } }
        PH_END
    }
    }
#undef PH_BEGIN
#undef PH_END
#undef adal
}

constexpr int N_PHASES = 2 + 2 * (NG * 7 + 5);

extern "C" void kernel_launch(void* const* d_in, const int* in_sizes, int n_in, void* d_out, int out_size, void* d_ws, size_t ws_size, hipStream_t stream) {
    static int grid = 0;
    if (grid == 0) {
        if (n_in != 32 || ws_size < WS_END) { fprintf(stderr, "kernel_launch: need 32 inputs and >= %zu bytes of workspace; got %d, %zu; nothing launched\n", (size_t)WS_END, n_in, ws_size); grid = -1; return; }
        int dev = 0, cus = 0, per_cu = 0;
        if (hipGetDevice(&dev) != hipSuccess || hipDeviceGetAttribute(&cus, hipDeviceAttributeMultiprocessorCount, dev) != hipSuccess) { grid = -1; return; }
        if (hipFuncSetAttribute((const void*)hse_fwd, hipFuncAttributeMaxDynamicSharedMemorySize, LDS_BYTES) != hipSuccess) { fprintf(stderr, "kernel_launch: hipFuncSetAttribute failed\n"); grid = -1; return; }
        if (hipOccupancyMaxActiveBlocksPerMultiprocessor(&per_cu, (const void*)hse_fwd, 512, LDS_BYTES) != hipSuccess || per_cu < 1) { fprintf(stderr, "kernel_launch: occupancy query says %d blocks per CU\n", per_cu); }
        (void)hipGetLastError();
        grid = cus;
    }
    if (grid < 0) return;
    (void)hipMemsetAsync((char*)d_ws + WS_CTL, 0, WS_CTL_BYTES, stream);
    Params p{};
    for (int i = 0; i < 32; ++i) p.in[i] = (const float*)d_in[i];
    p.out = (float*)d_out; p.ws = (unsigned char*)d_ws;
#if MK_ONE_LAUNCH
    p.ph_lo = 0; p.ph_hi = N_PHASES;
    hipLaunchKernelGGL(hse_fwd, dim3(grid), dim3(512), LDS_BYTES, stream, p);
#else
    for (int k = 0; k < N_PHASES; ++k) { p.ph_lo = k; p.ph_hi = k + 1; hipLaunchKernelGGL(hse_fwd, dim3(grid), dim3(512), LDS_BYTES, stream, p); }
#endif
}
```

```cpp
#include <hip/hip_runtime.h>
#include <cstdio>
#include <cstdint>

#ifndef MK_ONE_LAUNCH
#define MK_ONE_LAUNCH 1
#endif

#define LAS __attribute__((address_space(3)))
typedef unsigned short bf16_t;
typedef short bf16x8 __attribute__((ext_vector_type(8)));
typedef float f32x4 __attribute__((ext_vector_type(4)));
typedef float f32x2 __attribute__((ext_vector_type(2)));
typedef float f32x16 __attribute__((ext_vector_type(16)));
typedef unsigned u32x4 __attribute__((ext_vector_type(4)));
typedef unsigned u32x2 __attribute__((ext_vector_type(2)));

constexpr int DM = 2048, NB = 4, TT = 8192, MP = NB * TT, SB = 32, ST = 16, MS = SB * ST, MX = MP + MS;
constexpr int PAST = 1024, KVS = PAST + ST, KVROWS = MP + SB * KVS;
constexpr int NSTREAM = NB + SB, NADA = 6 * DM;
constexpr int NIN_SRC = 13120, NPROJ_ALL = 13312, NPROJ = 7168, DFF = 5632, NFAB = 2 * DFF;
constexpr int NG = 2;
constexpr int GPR = MP / NG, GXR = GPR + MS, GKV = GPR + SB * KVS, VT_LD = GKV + 64;
constexpr int GNB = NB / NG;
constexpr int PC_CQ = 0, PC_CKV = 512, PC_KR = 768, PC_QB = 1024, PC_KB = 2048, PC_VB = 3072, PC_QR = 4096, PC_KRR = 4608, PC_VR = 5120, PC_GR = 6144, PC_GA = 7168;
constexpr float LOG2E = 1.4426950408889634f;
constexpr float C_A = 0.10411754627697264f;
constexpr float C_B = 0.12751743082459868f;
constexpr float ALPHA = 1.4142135623730951f;
constexpr float EPS = 1e-5f;

constexpr size_t O_Y = 0, O_CKV_P = 68157440, O_KR_P = 84934656, O_BK_P = 89128960, O_BV_P = 93323264, O_RET_P = 97517568, O_CONV_P = 98041856,
                 O_CKV_S = 98131968, O_KR_S = 98394112, O_BK_S = 98459648, O_BV_S = 99508224, O_RET_S = 100556800, O_CONV_S = 104751104;

constexpr size_t al256(size_t x) { return (x + 255) & ~(size_t)255; }
constexpr size_t WS_CTL = 0, WS_CTL_BYTES = 65536;
constexpr size_t WS_ADA = WS_CTL + WS_CTL_BYTES;
constexpr size_t WS_ROPE = WS_ADA + al256((size_t)2 * NSTREAM * NADA * 4);
constexpr size_t WS_SQ = WS_ROPE + (size_t)TT * 32 * 8;
constexpr size_t WS_WT = WS_SQ + al256((size_t)MX * 4);
constexpr size_t WT_IN = 0, WT_UQ = WT_IN + (size_t)NPROJ_ALL * 2048, WT_UK = WT_UQ + (size_t)1536 * 512, WT_UV = WT_UK + (size_t)1024 * 256, WT_P = WT_UV + (size_t)1024 * 256,
                 WT_O = WT_P + (size_t)2048 * 3072, WT_FAB = WT_O + (size_t)2048 * 2048, WT_FD = WT_FAB + (size_t)NFAB * 2048, WT_END = WT_FD + (size_t)2048 * DFF;
constexpr size_t WS_H = WS_WT + al256(WT_END * 2);
constexpr size_t WS_XB = WS_H + (size_t)MX * DM * 2;
constexpr size_t WS_BIG = WS_XB + (size_t)MX * DM * 2;
constexpr size_t WB_PROJ = WS_BIG;
constexpr size_t WB_GATE = WB_PROJ + (size_t)GXR * NPROJ * 2;
constexpr size_t WB_Q = WB_GATE + (size_t)3 * (GXR / 256) * 8 * 65536 * 2;
constexpr size_t WB_CKV = WB_Q + (size_t)GXR * 1536 * 2;
constexpr size_t WB_KROPE = WB_CKV + (size_t)GKV * 256 * 2;
constexpr size_t WB_KNOPE = WB_KROPE + (size_t)(GKV + 64) * 64 * 2;
constexpr size_t WB_VT = WB_KNOPE + (size_t)(GKV + 64) * 1024 * 2;
constexpr size_t WB_OCAT = WB_VT + (size_t)1024 * VT_LD * 2;
constexpr size_t WB_MERGED = WB_KNOPE;
constexpr size_t WB_RETS = WB_OCAT + (size_t)GXR * 3072 * 2;
constexpr size_t WB_RETB = WB_RETS + (size_t)GNB * 8 * 128 * 8192 * 2;
constexpr size_t WB_END = WB_RETB + (size_t)GNB * 8 * 128 * 8192 * 2;
constexpr size_t WF_U = WS_BIG;
constexpr size_t WF_SIDE = WF_U + (size_t)MX * DFF * 2;
constexpr size_t WF_END = WF_SIDE + (size_t)(MX / 16) * 6 * DFF * 2;
constexpr size_t WS_END = (WB_END > WF_END ? WB_END : WF_END);

#define XB_TMO      128
#define XB_XCNT(j)  (256  + 64 * (j))
#define XB_XSUB(j)  (1280 + 64 * (j))
#define XB_XGEN(j)  (2304 + 64 * (j))
#define XB_TOP      3328
#define XB_TOPGEN   3392
#define XCD_BAR_WORDS 3456
#define XB_SPIN_CAP (1u << 22)
__device__ __forceinline__ unsigned xb_ld(unsigned* p)              { return __hip_atomic_load(p, __ATOMIC_RELAXED, __HIP_MEMORY_SCOPE_AGENT); }
__device__ __forceinline__ unsigned xb_add(unsigned* p, unsigned v) { return __hip_atomic_fetch_add(p, v, __ATOMIC_RELAXED, __HIP_MEMORY_SCOPE_AGENT); }
__device__ __forceinline__ unsigned xb_xcc_id() { return (unsigned)__builtin_amdgcn_s_getreg((3 << 11) | 20) & 0xFu; }
#define XB_SPIN(cond, bar) do { unsigned _sp = 0; while (cond) { __builtin_amdgcn_s_sleep(1); \
    if ((++_sp & 255u) == 0u) { if (xb_ld(&(bar)[XB_TMO])) break; if (_sp > XB_SPIN_CAP) { atomicAdd(&(bar)[XB_TMO], 1u); break; } } } } while (0)
struct XcdBarrier { unsigned* bar; unsigned x; volatile LAS unsigned* st; };
__device__ __forceinline__ XcdBarrier xcd_barrier_post(unsigned* bar, volatile LAS unsigned* st) {
    XcdBarrier b; b.bar = bar; b.x = xb_xcc_id(); b.st = st;
    if (threadIdx.x == 0) (void)xb_add(&bar[XB_XCNT(b.x)], 1u);
    return b;
}
__device__ __forceinline__ void xcd_barrier_complete(unsigned* bar, unsigned x, unsigned& nloc, unsigned& nx) {
    const unsigned G = gridDim.x * gridDim.y * gridDim.z;
    unsigned sum, cnt, mine, sp = 0u;
    for (;;) {
        sum = 0u; cnt = 0u; mine = 0u;
#pragma unroll
        for (unsigned j = 0; j < 16; ++j) { const unsigned c = xb_ld(&bar[XB_XCNT(j)]); sum += c; cnt += (c > 0u) ? 1u : 0u; mine = (j == x) ? c : mine; }
        if (sum == G) break;
        __builtin_amdgcn_s_sleep(1);
        if ((++sp & 255u) == 0u) { if (xb_ld(&bar[XB_TMO])) break; if (sp > XB_SPIN_CAP) { atomicAdd(&bar[XB_TMO], 1u); break; } }
    }
    nloc = mine > 0u ? mine : 1u; nx = cnt > 0u ? cnt : 1u;
}
__device__ __forceinline__ void xcd_barrier(const XcdBarrier& b, const int tid0) {
    asm volatile("s_waitcnt vmcnt(0)" ::: "memory");
    __syncthreads();
    if (tid0 == 0) {
        unsigned* bar = b.bar;
        __builtin_amdgcn_s_waitcnt(0);
        unsigned nloc = b.st[0], nx = b.st[1];
        if (nloc == 0u) { xcd_barrier_complete(bar, b.x, nloc, nx); b.st[0] = nloc; b.st[1] = nx; }
        const unsigned old = xb_add(&bar[XB_XSUB(b.x)], 1u);
        const unsigned gen = old / nloc;
        if (old + 1u == (gen + 1u) * nloc) {
            __builtin_amdgcn_fence(__ATOMIC_RELEASE, "agent");
            asm volatile("s_waitcnt vmcnt(0)" ::: "memory");
            const unsigned og = xb_add(&bar[XB_TOP], 1u);
            const unsigned tg = og / nx;
            if (og + 1u == (tg + 1u) * nx) xb_add(&bar[XB_TOPGEN], 1u);
            else XB_SPIN(xb_ld(&bar[XB_TOPGEN]) == tg, bar);
            __builtin_amdgcn_fence(__ATOMIC_ACQUIRE, "agent");
            xb_add(&bar[XB_XGEN(b.x)], 1u);
            asm volatile("s_waitcnt vmcnt(0)" ::: "memory");
        } else {
            XB_SPIN(xb_ld(&bar[XB_XGEN(b.x)]) == gen, bar);
            __builtin_amdgcn_fence(__ATOMIC_ACQUIRE, "agent");
            asm volatile("s_waitcnt vmcnt(0)" ::: "memory");
        }
    }
    __syncthreads();
}

__device__ __forceinline__ unsigned cvt_pk_bf16(float lo, float hi) { unsigned r; asm volatile("v_cvt_pk_bf16_f32 %0, %1, %2" : "=v"(r) : "v"(lo), "v"(hi)); return r; }
__device__ __forceinline__ float bf_lo(unsigned w) { return __uint_as_float(w << 16); }
__device__ __forceinline__ float bf_hi(unsigned w) { return __uint_as_float(w & 0xffff0000u); }
__device__ __forceinline__ float wave_sum(float v) {
    v += __int_as_float(__builtin_amdgcn_ds_swizzle(__float_as_int(v), 0x041F));
    v += __int_as_float(__builtin_amdgcn_ds_swizzle(__float_as_int(v), 0x081F));
    v += __int_as_float(__builtin_amdgcn_ds_swizzle(__float_as_int(v), 0x101F));
    v += __int_as_float(__builtin_amdgcn_ds_swizzle(__float_as_int(v), 0x201F));
    v += __int_as_float(__builtin_amdgcn_ds_swizzle(__float_as_int(v), 0x401F));
    auto rr = __builtin_amdgcn_permlane32_swap(__float_as_uint(v), __float_as_uint(v), false, false);
    return __uint_as_float(rr[0]) + __uint_as_float(rr[1]);
}
__device__ __forceinline__ int opaque_tid(int wave_s) { int t; asm volatile("v_mbcnt_lo_u32_b32 %0, -1, 0\n\tv_mbcnt_hi_u32_b32 %0, -1, %0" : "=v"(t)); return (wave_s << 6) | t; }
__device__ __forceinline__ int lane_id_v() { int t; asm volatile("v_mbcnt_lo_u32_b32 %0, -1, 0\n\tv_mbcnt_hi_u32_b32 %0, -1, %0" : "=v"(t)); return t; }
__device__ __forceinline__ float fast_rcp(float x) { return __builtin_amdgcn_rcpf(x); }
__device__ __forceinline__ float sigmoidf_(float x) { return fast_rcp(1.0f + __builtin_amdgcn_exp2f(-x * LOG2E)); }
__device__ __forceinline__ int row_stream(int ar) { return ar < MP ? (ar >> 13) : NB + ((ar - MP) >> 4); }
__device__ __forceinline__ int row_pos(int ar) { return ar < MP ? (ar & (TT - 1)) : PAST + ((ar - MP) & 15); }
__device__ __forceinline__ int row_kv(int ar) { return ar < MP ? ar : MP + ((ar - MP) >> 4) * KVS + PAST + ((ar - MP) & 15); }
__device__ __forceinline__ float lg2_gamma(int h) {
    return h == 0 ? -0.04580368961312479f : h == 1 ? -0.02272007650008353f : h == 2 ? -0.011315313227834146f : h == 3 ? -0.005646563141142063f :
           h == 4 ? -0.0028205190623786626f : h == 5 ? -0.0014095702546713536f : h == 6 ? -0.0007046129765893727f : -0.0003522634716290214f;
}
__device__ __forceinline__ float gelu1(float v) {
    const float av = fabsf(v), d = av * 0.2316418882f + 1.0f;
    const float t = __builtin_amdgcn_rcpf(d);
    float q = t * 0.5307027145f + (-0.7265760135f); q = q * t + 0.7107068705f; q = q * t + (-0.142248368f); q = q * t + 0.127414796f; q = q * t;
    const float e = __builtin_amdgcn_exp2f((v * v) * (-0.72134752044f));
    const float m = v * (q * e), r = v - m;
    return v < 0.f ? m : r;
}

struct Params {
    const float* in[32];
    float* out;
    unsigned char* ws;
    int ph_lo, ph_hi;
};
struct PT { LAS unsigned long long* t;
    __device__ __forceinline__ const float* in(int k) const { const unsigned long long v = t[k]; const unsigned lo = __builtin_amdgcn_readfirstlane((unsigned)v), hi = __builtin_amdgcn_readfirstlane((unsigned)(v >> 32)); return (const float*)(const __attribute__((address_space(1))) float*)(((unsigned long long)hi << 32) | lo); }
};

namespace pg8 {
constexpr int BM = 256, BK = 64, HALF = 128, HTB = HALF * BK * 2, STAGE_BYTES = 8 * HTB, NXCD = 8, WGM = 4;
__host__ __device__ __forceinline__ int lds_byte(int r, int c) { const int st = (r >> 4) * 2 + (c >> 5), rr = r & 15, cc = c & 31, ob = rr * 64 + cc * 2; return st * 1024 + (ob ^ (((ob >> 9) & 1) << 5)); }
__host__ __device__ __forceinline__ void stage_rc(int b, int& R, int& C) { const int st = b / 1024, sb = b % 1024, swz = sb ^ (((sb >> 9) & 1) << 5); R = (st >> 1) * 16 + swz / 64; C = (st & 1) * 32 + (swz % 64) / 2; }
__host__ __device__ __forceinline__ int perm32(int rho) { const int n = rho >> 4, i = rho & 15; return 8 * (i >> 2) + 4 * n + (i & 3); }
struct Unit { int pm, pn; };
struct Gemm { const bf16_t* A; const bf16_t* Bt; int M, N, K, lda, ldb; };
struct StaticOrder {
    int nM, nN, nwg, G, c;
    __host__ __device__ void init(int M, int N, int G_, int c_) { nM = M / BM; nN = N / BM; nwg = nM * nN; G = G_; c = c_; }
    __host__ __device__ bool next(int i, Unit& u) const {
        const long L = (long)i * G + c; if (L >= nwg) return false;
        int wgid = (int)L; { const int q = nwg / NXCD, r = nwg % NXCD, xcd = wgid % NXCD, off = wgid / NXCD; wgid = (xcd < r ? xcd * (q + 1) : r * (q + 1) + (xcd - r) * q) + off; }
        const int nig = WGM * nN, gid = wgid / nig, fm = gid * WGM, gsz = (nM - fm) < WGM ? (nM - fm) : WGM;
        u.pm = fm + ((wgid % nig) % gsz); u.pn = (wgid % nig) / gsz; return true;
    }
};

template <class Epi>
__device__ __forceinline__ void gemm_phase(const int tid, LAS unsigned char* lds, const Gemm g, const StaticOrder& S, const Epi& E) {
    const int wid = __builtin_amdgcn_readfirstlane(tid >> 6), lane = tid & 63, wr = wid >> 2, wc = wid & 3, fr = lane & 15, fq = lane >> 4;
    const int K = g.K, nt = K / BK;
    unsigned voffA[2], voffB[2];
#pragma unroll
    for (int i = 0; i < 2; ++i) { int R, C; stage_rc(tid * 16 + i * 8192, R, C); const int Rb = Epi::PERM ? ((R & ~31) + perm32(R & 31)) : R;
        voffA[i] = (unsigned)(R * g.lda + C) * 2u; voffB[i] = (unsigned)(Rb * g.ldb + C) * 2u; }
    const size_t kstep = (size_t)(BK * 2);
    const size_t hstepA = (size_t)HALF * g.lda * 2, hstepB = (size_t)HALF * g.ldb * 2;
    const size_t tstepA = 2 * hstepA, tstepB = 2 * hstepB;
    const unsigned ldsw = (unsigned)wid * 1024u;
    const int aoff = lds_byte(wr * 64 + fr, fq * 8), boff = lds_byte(wc * 32 + fr, fq * 8);
#define PG8_SA(b, h) (((b) * 2 + (h)) * HTB)
#define PG8_SB(b, h) ((4 + (b) * 2 + (h)) * HTB)
#define PG8_STAGE(bufoff, gbase, voff) do { _Pragma("unroll") for (int _i = 0; _i < 2; ++_i) \
        __builtin_amdgcn_global_load_lds((const unsigned*)((const char*)(gbase) + (voff)[_i]), (LAS unsigned*)(lds + (bufoff) + ldsw + _i * 8192), 16, 0, 0); } while (0)
#define PG8_LDA(dst, b, h) do { _Pragma("unroll") for (int m = 0; m < 4; ++m) _Pragma("unroll") for (int k = 0; k < 2; ++k) dst[m][k] = *(const LAS bf16x8*)(lds + PG8_SA(b, h) + aoff + m * 2048 + k * 1024); } while (0)
#define PG8_LDB(dst, b, h) do { _Pragma("unroll") for (int n = 0; n < 2; ++n) _Pragma("unroll") for (int k = 0; k < 2; ++k) dst[n][k] = *(const LAS bf16x8*)(lds + PG8_SB(b, h) + boff + n * 2048 + k * 1024); } while (0)
#define PG8_MMA(ai, bj, At, Bt) do { __builtin_amdgcn_s_setprio(1); _Pragma("unroll") for (int m = 0; m < 4; ++m) _Pragma("unroll") for (int n = 0; n < 2; ++n) _Pragma("unroll") for (int k = 0; k < 2; ++k) \
        acc[ai][bj][m][n] = __builtin_amdgcn_mfma_f32_16x16x32_bf16(Bt[n][k], At[m][k], acc[ai][bj][m][n], 0, 0, 0); __builtin_amdgcn_s_setprio(0); } while (0)
#define PG8_WAIT_V(n) asm volatile("s_waitcnt vmcnt(" #n ")" ::: "memory")
#define PG8_WAIT_L(n) asm volatile("s_waitcnt lgkmcnt(" #n ")" ::: "memory")
#define PG8_BAR __builtin_amdgcn_s_barrier()
#define PG8_SCHED __builtin_amdgcn_sched_barrier(0)
    Unit cur, nxt; int ui = 0;
    if (!S.next(0, cur)) return;
    f32x4 acc[2][2][4][2];
#pragma unroll
    for (int a = 0; a < 2; ++a)
#pragma unroll
        for (int b = 0; b < 2; ++b)
#pragma unroll
            for (int m = 0; m < 4; ++m)
#pragma unroll
                for (int n = 0; n < 2; ++n) acc[a][b][m][n] = (f32x4){0.f, 0.f, 0.f, 0.f};
    bf16x8 At[4][2], B0[2][2], B1[2][2];
    const char* cA = (const char*)g.A + (size_t)cur.pm * tstepA; const char* cB = (const char*)g.Bt + (size_t)cur.pn * tstepB;
    PG8_STAGE(PG8_SB(0, 0), cB, voffB); PG8_STAGE(PG8_SB(0, 1), cB + hstepB, voffB); PG8_STAGE(PG8_SA(0, 0), cA, voffA); PG8_STAGE(PG8_SA(0, 1), cA + hstepA, voffA);
    if (wr == 1) PG8_BAR;
    PG8_WAIT_V(2); PG8_BAR;
    PG8_STAGE(PG8_SB(1, 0), cB + kstep, voffB); PG8_STAGE(PG8_SA(1, 0), cA + kstep, voffA); PG8_STAGE(PG8_SB(1, 1), cB + hstepB + kstep, voffB);
    PG8_WAIT_V(6); PG8_BAR;
    for (;;) {
        const bool has_next = S.next(ui + 1, nxt);
        const char* nA = has_next ? (const char*)g.A + (size_t)nxt.pm * tstepA : cA; const char* nB = has_next ? (const char*)g.Bt + (size_t)nxt.pn * tstepB : cB;
        for (int t = 0; t < nt; t += 2) {
            const bool last = (t == nt - 2);
            const char* a1 = cA + (size_t)(t + 1) * kstep;
            const char* a2 = last ? nA : cA + (size_t)(t + 2) * kstep; const char* b2 = last ? nB : cB + (size_t)(t + 2) * kstep;
            const char* a3 = a2 + kstep; const char* b3 = b2 + kstep;
            if constexpr (Epi::HOOK) { if (t == 16 || t == 32) { PG8_SCHED; E.hook(acc, cur, t == 16 ? 0 : 1, wr, wc, fr, fq); PG8_SCHED; } }
            PG8_LDB(B0, 0, 0); PG8_LDB(B1, 0, 1); PG8_SCHED; PG8_LDA(At, 0, 0); PG8_STAGE(PG8_SA(1, 1), a1 + hstepA, voffA);
            PG8_WAIT_V(8); PG8_WAIT_L(0); PG8_BAR; PG8_MMA(0, 0, At, B0); PG8_MMA(0, 1, At, B1); PG8_BAR; PG8_SCHED;
            PG8_LDA(At, 0, 1); PG8_STAGE(PG8_SB(0, 0), b2, voffB); PG8_STAGE(PG8_SB(0, 1), b2 + hstepB, voffB); PG8_STAGE(PG8_SA(0, 0), a2, voffA);
            PG8_WAIT_V(8); PG8_WAIT_L(0); PG8_BAR; PG8_MMA(1, 0, At, B0); PG8_MMA(1, 1, At, B1); PG8_BAR; PG8_SCHED;
            PG8_LDB(B0, 1, 0); PG8_LDB(B1, 1, 1); PG8_SCHED; PG8_LDA(At, 1, 0); PG8_STAGE(PG8_SA(0, 1), a2 + hstepA, voffA);
            PG8_WAIT_V(8); PG8_WAIT_L(0); PG8_BAR; PG8_MMA(0, 0, At, B0); PG8_MMA(0, 1, At, B1); PG8_BAR; PG8_SCHED;
            PG8_LDA(At, 1, 1); PG8_STAGE(PG8_SB(1, 0), b3, voffB); PG8_STAGE(PG8_SB(1, 1), b3 + hstepB, voffB); PG8_STAGE(PG8_SA(1, 0), a3, voffA);
            PG8_WAIT_V(8); PG8_WAIT_L(0); PG8_BAR; PG8_MMA(1, 0, At, B0); PG8_MMA(1, 1, At, B1); PG8_BAR; PG8_SCHED;
        }
        if (wr == 0) PG8_BAR;
        E(acc, cur, wr, wc, fr, fq);
        if (!has_next) break;
#pragma unroll
        for (int a = 0; a < 2; ++a)
#pragma unroll
            for (int b = 0; b < 2; ++b)
#pragma unroll
                for (int m = 0; m < 4; ++m)
#pragma unroll
                    for (int n = 0; n < 2; ++n) acc[a][b][m][n] = (f32x4){0.f, 0.f, 0.f, 0.f};
        cur = nxt; cA = nA; cB = nB; ++ui;
        if (wr == 1) PG8_BAR;
    }
    PG8_WAIT_V(0);
    PG8_BAR;
#undef PG8_SA
#undef PG8_SB
#undef PG8_STAGE
#undef PG8_LDA
#undef PG8_LDB
#undef PG8_MMA
#undef PG8_WAIT_V
#undef PG8_WAIT_L
#undef PG8_BAR
#undef PG8_SCHED
}
}
using pg8::Unit;

struct EpiProj {
    static constexpr bool PERM = true, HOOK = false;
    bf16_t* O; bf16_t* GB;
    __device__ __forceinline__ void operator()(const f32x4 (&acc)[2][2][4][2], const Unit& u, int wr, int wc, int, int) const {
        const int ln_ = lane_id_v(); const int fr = ln_ & 15, fq = ln_ >> 4;
        const int pn = u.pn; const int mode = (pn >= 28) ? 2 : (pn >= 24 ? 1 : ((pn >= 4 && pn < 8) ? 3 : 0));
        bf16_t* base; int ld;
        if (mode == 2) { const int br = (pn - 28) >> 3, pnl = (pn - 28) & 7; base = GB + (((size_t)br * (GXR / 256) + u.pm) * 8 + pnl) * 65536 + (size_t)(wr * 64 + fr) * 256 + wc * 32 + 8 * fq; ld = 256; }
        else { base = O + (size_t)(u.pm * 256 + wr * 64 + fr) * NPROJ + u.pn * 256 + wc * 32 + 8 * fq; ld = NPROJ; }
#pragma unroll
        for (int ai = 0; ai < 2; ++ai)
#pragma unroll
            for (int m = 0; m < 4; ++m) { bf16_t* rowp = base + (size_t)(ai * 128 + m * 16) * ld;
#pragma unroll
                for (int bj = 0; bj < 2; ++bj) { f32x4 v0 = acc[ai][bj][m][0], v1 = acc[ai][bj][m][1];
                    if (mode == 2) {
#pragma unroll
                        for (int j = 0; j < 4; ++j) { v0[j] = sigmoidf_(v0[j]); v1[j] = sigmoidf_(v1[j]); } }
                    else if (mode == 1) {
#pragma unroll
                        for (int j = 0; j < 4; ++j) { v0[j] = v0[j] * sigmoidf_(v0[j]); v1[j] = v1[j] * sigmoidf_(v1[j]); } }
                    else if (mode == 3) { v0 *= C_B; v1 *= C_B; }
                    u32x4 w; w.x = cvt_pk_bf16(v0[0], v0[1]); w.y = cvt_pk_bf16(v0[2], v0[3]); w.z = cvt_pk_bf16(v1[0], v1[1]); w.w = cvt_pk_bf16(v1[2], v1[3]);
                    *(u32x4*)(rowp + bj * 128) = w; } }
    }
    __device__ __forceinline__ void hook(f32x4 (&)[2][2][4][2], const Unit&, int, int, int, int, int) const {}
};
template <int ldc> struct EpiPlain {
    static constexpr bool PERM = true, HOOK = false;
    bf16_t* O;
    __device__ __forceinline__ void operator()(const f32x4 (&acc)[2][2][4][2], const Unit& u, int wr, int wc, int, int) const {
        const int ln_ = lane_id_v(); const int fr = ln_ & 15, fq = ln_ >> 4;
        const int row0 = u.pm * 256 + wr * 64 + fr, col0 = u.pn * 256 + wc * 32 + 8 * fq;
#pragma unroll
        for (int ai = 0; ai < 2; ++ai)
#pragma unroll
            for (int m = 0; m < 4; ++m) { bf16_t* rowp = O + (size_t)(row0 + ai * 128 + m * 16) * ldc + col0;
#pragma unroll
                for (int bj = 0; bj < 2; ++bj) { const f32x4 v0 = acc[ai][bj][m][0], v1 = acc[ai][bj][m][1];
                    u32x4 w; w.x = cvt_pk_bf16(v0[0], v0[1]); w.y = cvt_pk_bf16(v0[2], v0[3]); w.z = cvt_pk_bf16(v1[0], v1[1]); w.w = cvt_pk_bf16(v1[2], v1[3]);
                    *(u32x4*)(rowp + bj * 128) = w; } }
    }
    __device__ __forceinline__ void hook(f32x4 (&)[2][2][4][2], const Unit&, int, int, int, int, int) const {}
};
struct EpiQ {
    static constexpr bool PERM = true, HOOK = false;
    bf16_t* Q; const float* sq; const float* rope; int xrow0;
    __device__ __forceinline__ void operator()(const f32x4 (&acc)[2][2][4][2], const Unit& u, int wr, int wc, int, int) const {
        const int ln_ = lane_id_v(); const int fr = ln_ & 15, fq = ln_ >> 4;
        const int row0 = u.pm * 256 + wr * 64 + fr, col0 = u.pn * 256 + wc * 32 + 8 * fq;
        const int j0 = col0 % 192, j1 = (col0 + 128) % 192;
        const int rb = j0 >= 128 ? 0 : (j1 >= 128 ? 1 : -1), jr = (rb == 0 ? j0 : j1) - 128;
        float sc[2][4]; f32x4 t0[2][4], t1[2][4];
#pragma unroll
        for (int ai = 0; ai < 2; ++ai)
#pragma unroll
            for (int m = 0; m < 4; ++m) { const int ar = xrow0 + row0 + ai * 128 + m * 16; sc[ai][m] = sq[ar] * C_A; t0[ai][m] = (f32x4){1.f, 0.f, 1.f, 0.f}; t1[ai][m] = t0[ai][m];
                if (rb >= 0) { const float* tp = rope + ((size_t)row_pos(ar) * 32 + (jr >> 1)) * 2; t0[ai][m] = *(const f32x4*)tp; t1[ai][m] = *(const f32x4*)(tp + 4); } }
#pragma unroll
        for (int ai = 0; ai < 2; ++ai)
#pragma unroll
            for (int m = 0; m < 4; ++m) { const int r = row0 + ai * 128 + m * 16; const float s = sc[ai][m];
                bf16_t* rowp = Q + (size_t)r * 1536 + col0;
#pragma unroll
                for (int bj = 0; bj < 2; ++bj) { f32x4 v0 = acc[ai][bj][m][0] * s, v1 = acc[ai][bj][m][1] * s;
                    if (bj == rb) { const f32x4 c0 = t0[ai][m], c1 = t1[ai][m];
                        f32x4 a, b;
                        a[0] = v0[0] * c0[0] - v0[1] * c0[1]; a[1] = v0[1] * c0[0] + v0[0] * c0[1]; a[2] = v0[2] * c0[2] - v0[3] * c0[3]; a[3] = v0[3] * c0[2] + v0[2] * c0[3];
                        b[0] = v1[0] * c1[0] - v1[1] * c1[1]; b[1] = v1[1] * c1[0] + v1[0] * c1[1]; b[2] = v1[2] * c1[2] - v1[3] * c1[3]; b[3] = v1[3] * c1[2] + v1[2] * c1[3];
                        v0 = a; v1 = b; }
                    u32x4 w; w.x = cvt_pk_bf16(v0[0], v0[1]); w.y = cvt_pk_bf16(v0[2], v0[3]); w.z = cvt_pk_bf16(v1[0], v1[1]); w.w = cvt_pk_bf16(v1[2], v1[3]);
                    *(u32x4*)(rowp + bj * 128) = w; } }
    }
    __device__ __forceinline__ void hook(f32x4 (&)[2][2][4][2], const Unit&, int, int, int, int, int) const {}
};
struct EpiMerge {
    static constexpr bool PERM = true, HOOK = true;
    bf16_t* O; const bf16_t* GB;
    static constexpr size_t BRS = (size_t)(GXR / 256) * 8 * 65536;
    __device__ __forceinline__ void hook(f32x4 (&acc)[2][2][4][2], const Unit& u, int which, int wr, int wc, int, int) const {
        const int ln_ = lane_id_v(); const int fr = ln_ & 15, fq = ln_ >> 4;
        int rt = wr * 64 + fr; asm volatile("" : "+v"(rt));
        const bf16_t* g1 = GB + (size_t)which * BRS + ((size_t)u.pm * 8 + u.pn) * 65536 + (size_t)rt * 256 + wc * 32 + 8 * fq;
        u32x4 a[2][2][2], b[2][2][2];
#define HK_LD(bu, st) do { _Pragma("unroll") for (int mm = 0; mm < 2; ++mm) _Pragma("unroll") for (int bj = 0; bj < 2; ++bj) { \
            const bf16_t* p = g1 + (((st) >> 1) * 128 + (((st) & 1) * 2 + mm) * 16) * 256 + bj * 128; a[bu][mm][bj] = *(const u32x4*)p; b[bu][mm][bj] = *(const u32x4*)(p + BRS); } } while (0)
#define HK_MUL(bu, st) do { _Pragma("unroll") for (int mm = 0; mm < 2; ++mm) _Pragma("unroll") for (int bj = 0; bj < 2; ++bj) { const u32x4 x = a[bu][mm][bj], y = b[bu][mm][bj]; f32x4 r0, r1; \
            r0[0] = bf_lo(x.x) * fast_rcp(fmaxf(bf_lo(y.x), 1e-30f)); r0[1] = bf_hi(x.x) * fast_rcp(fmaxf(bf_hi(y.x), 1e-30f)); \
            r0[2] = bf_lo(x.y) * fast_rcp(fmaxf(bf_lo(y.y), 1e-30f)); r0[3] = bf_hi(x.y) * fast_rcp(fmaxf(bf_hi(y.y), 1e-30f)); \
            r1[0] = bf_lo(x.z) * fast_rcp(fmaxf(bf_lo(y.z), 1e-30f)); r1[1] = bf_hi(x.z) * fast_rcp(fmaxf(bf_hi(y.z), 1e-30f)); \
            r1[2] = bf_lo(x.w) * fast_rcp(fmaxf(bf_lo(y.w), 1e-30f)); r1[3] = bf_hi(x.w) * fast_rcp(fmaxf(bf_hi(y.w), 1e-30f)); \
            acc[(st) >> 1][bj][((st) & 1) * 2 + mm][0] *= r0; acc[(st) >> 1][bj][((st) & 1) * 2 + mm][1] *= r1; } } while (0)
        HK_LD(0, 0);
        HK_LD(1, 1); asm volatile("s_waitcnt vmcnt(8)" ::: "memory"); HK_MUL(0, 0);
        HK_LD(0, 2); asm volatile("s_waitcnt vmcnt(8)" ::: "memory"); HK_MUL(1, 1);
        HK_LD(1, 3); asm volatile("s_waitcnt vmcnt(8)" ::: "memory"); HK_MUL(0, 2);
        asm volatile("s_waitcnt vmcnt(0)" ::: "memory"); HK_MUL(1, 3);
        asm volatile("" ::: "memory");
#undef HK_LD
#undef HK_MUL
    }
    __device__ __forceinline__ void operator()(const f32x4 (&acc)[2][2][4][2], const Unit& u, int wr, int wc, int, int) const {
        const int ln_ = lane_id_v(); const int fr = ln_ & 15, fq = ln_ >> 4;
        const int row0 = u.pm * 256 + wr * 64 + fr, col0 = u.pn * 256 + wc * 32 + 8 * fq;
        const bf16_t* g1 = GB + 2 * BRS + ((size_t)u.pm * 8 + u.pn) * 65536 + (size_t)(wr * 64 + fr) * 256 + wc * 32 + 8 * fq;
        u32x4 y[2][4][2];
#pragma unroll
        for (int ai = 0; ai < 2; ++ai)
#pragma unroll
            for (int m = 0; m < 4; ++m)
#pragma unroll
                for (int bj = 0; bj < 2; ++bj) y[ai][m][bj] = *(const u32x4*)(g1 + (ai * 128 + m * 16) * 256 + bj * 128);
#pragma unroll
        for (int ai = 0; ai < 2; ++ai) {
#pragma unroll
            for (int m = 0; m < 4; ++m) { bf16_t* rowp = O + (size_t)(row0 + ai * 128 + m * 16) * 2048 + col0;
#pragma unroll
                for (int bj = 0; bj < 2; ++bj) { const u32x4 g = y[ai][m][bj]; const f32x4 v0 = acc[ai][bj][m][0], v1 = acc[ai][bj][m][1];
                    u32x4 w; w.x = cvt_pk_bf16(v0[0] * bf_lo(g.x), v0[1] * bf_hi(g.x)); w.y = cvt_pk_bf16(v0[2] * bf_lo(g.y), v0[3] * bf_hi(g.y));
                    w.z = cvt_pk_bf16(v1[0] * bf_lo(g.z), v1[1] * bf_hi(g.z)); w.w = cvt_pk_bf16(v1[2] * bf_lo(g.w), v1[3] * bf_hi(g.w));
                    *(u32x4*)(rowp + bj * 128) = w; } }
            asm volatile("" ::: "memory"); }
    }
};
struct EpiGate {
    static constexpr bool PERM = true, HOOK = false;
    bf16_t* O; const float* gt; int xrow0;
    __device__ __forceinline__ void operator()(const f32x4 (&acc)[2][2][4][2], const Unit& u, int wr, int wc, int, int) const {
        const int ln_ = lane_id_v(); const int fr = ln_ & 15, fq = ln_ >> 4;
        const int row0 = u.pm * 256 + wr * 64 + fr, col0 = u.pn * 256 + wc * 32 + 8 * fq;
        const int tile_row = xrow0 + u.pm * 256;
        const float* gr = gt + (size_t)(tile_row >> 13) * NADA + col0;
        f32x4 g[2][2];
#pragma unroll
        for (int bj = 0; bj < 2; ++bj) { g[bj][0] = *(const f32x4*)(gr + bj * 128) + 1.0f; g[bj][1] = *(const f32x4*)(gr + bj * 128 + 4) + 1.0f; }
#pragma unroll
        for (int ai = 0; ai < 2; ++ai)
#pragma unroll
            for (int m = 0; m < 4; ++m) { bf16_t* op = O + (size_t)(xrow0 + row0 + ai * 128 + m * 16) * DM + col0;
#pragma unroll
                for (int bj = 0; bj < 2; ++bj) { const f32x4 v0 = acc[ai][bj][m][0] * g[bj][0], v1 = acc[ai][bj][m][1] * g[bj][1];
                    u32x4 w; w.x = cvt_pk_bf16(v0[0], v0[1]); w.y = cvt_pk_bf16(v0[2], v0[3]); w.z = cvt_pk_bf16(v1[0], v1[1]); w.w = cvt_pk_bf16(v1[2], v1[3]);
                    *(u32x4*)(op + bj * 128) = w; } }
    }
    __device__ __forceinline__ void hook(f32x4 (&)[2][2][4][2], const Unit&, int, int, int, int, int) const {}
};

__device__ __forceinline__ f32x4 mfma16(bf16x8 a, bf16x8 b, f32x4 c) { return __builtin_amdgcn_mfma_f32_16x16x32_bf16(a, b, c, 0, 0, 0); }
__device__ __forceinline__ void skinny_kloop(f32x4 (&acc)[4][4], const char* pa, const char* pb, const unsigned (&va)[4], const unsigned (&vb)[4], const int nc) {
    bf16x8 fa[2][2][4], fb[2][2][4];
#define SK_LD(bu, PA, PB) do { _Pragma("unroll") for (int k_ = 0; k_ < 2; ++k_) _Pragma("unroll") for (int i_ = 0; i_ < 4; ++i_) { fa[bu][k_][i_] = *(const bf16x8*)((PA) + va[i_] + k_ * 64); fb[bu][k_][i_] = *(const bf16x8*)((PB) + vb[i_] + k_ * 64); } } while (0)
#define SK_MM(bu) do { _Pragma("unroll") for (int k_ = 0; k_ < 2; ++k_) _Pragma("unroll") for (int m_ = 0; m_ < 4; ++m_) _Pragma("unroll") for (int n_ = 0; n_ < 4; ++n_) acc[m_][n_] = mfma16(fb[bu][k_][n_], fa[bu][k_][m_], acc[m_][n_]); } while (0)
    SK_LD(0, pa, pb);
#pragma unroll 1
    for (int c = 0; c < nc; c += 2) {
        const int o1 = (c + 1 < nc) ? 128 : 0, o2 = (c + 2 < nc) ? 256 : 0;
        SK_LD(1, pa + o1, pb + o1);
        SK_MM(0);
        SK_LD(0, pa + o2, pb + o2);
        if (c + 1 < nc) SK_MM(1);
        pa += 256; pb += 256;
    }
#undef SK_LD
#undef SK_MM
}
struct SkNoPre { __device__ __forceinline__ void operator()(f32x4 (&)[4][4], int, int, int, int) const {} };
struct SkGateFin {
    bf16_t* O; const float* gt;
    __device__ __forceinline__ void operator()(int r, int c, const f32x4& s) const { const int ar = MP + r; const f32x4 g = *(const f32x4*)(gt + (size_t)row_stream(ar) * NADA + c) + 1.0f; const f32x4 v = s * g;
        *(u32x2*)(O + (size_t)ar * DM + c) = (u32x2){cvt_pk_bf16(v[0], v[1]), cvt_pk_bf16(v[2], v[3])}; }
};
struct SkMergePre {
    const bf16_t* GB; int br;
    __device__ __forceinline__ void operator()(f32x4 (&acc)[4][4], int row0, int col0, int fr, int fq) const {
        const bf16_t* g0 = GB + (size_t)br * EpiMerge::BRS + ((size_t)(GPR / 256 + (row0 >> 8)) * 8 + (col0 >> 8)) * 65536 + (size_t)((row0 & 255) + fr) * 256 + (col0 & 255) + 4 * fq;
        u32x2 gw[4][4];
#pragma unroll
        for (int m = 0; m < 4; ++m)
#pragma unroll
            for (int n = 0; n < 4; ++n) gw[m][n] = *(const u32x2*)(g0 + m * 16 * 256 + n * 16);
#pragma unroll
        for (int m = 0; m < 4; ++m)
#pragma unroll
            for (int n = 0; n < 4; ++n) { const u32x2 g = gw[m][n]; acc[m][n] *= (f32x4){bf_lo(g.x), bf_hi(g.x), bf_lo(g.y), bf_hi(g.y)}; }
    }
};
struct SkMergeFin { bf16_t* O;
    __device__ __forceinline__ void operator()(int r, int c, const f32x4& s) const { *(u32x2*)(O + (size_t)(GPR + r) * 2048 + c) = (u32x2){cvt_pk_bf16(s[0], s[1]), cvt_pk_bf16(s[2], s[3])}; }
};
template <class Pre, class Fin>
__device__ __forceinline__ void skinny_tiles(const int tid, LAS unsigned char* lds, const bf16_t* A, const int lda, const bf16_t* Bt, const int ldb, const int kch0, const int nc, const int G, const int bid, const Pre& pre, const Fin& fin) {
    const int lane = tid & 63, w = __builtin_amdgcn_readfirstlane(tid >> 6), fr = lane & 15, fq = lane >> 4;
    LAS f32x4* red = (LAS f32x4*)lds;
    unsigned va[4], vb[4];
#pragma unroll
    for (int i = 0; i < 4; ++i) { va[i] = (unsigned)((16 * i + fr) * lda + 8 * fq) * 2u; vb[i] = (unsigned)((16 * i + fr) * ldb + 8 * fq) * 2u; }
    for (int t = bid; t < 256; t += G) {
        const int x = t & 7, j = t >> 3, row0 = (j >> 2) * 64, col0 = (x * 4 + (j & 3)) * 64;
        f32x4 acc[4][4];
#pragma unroll
        for (int m = 0; m < 4; ++m)
#pragma unroll
            for (int n = 0; n < 4; ++n) acc[m][n] = (f32x4){0.f, 0.f, 0.f, 0.f};
        skinny_kloop(acc, (const char*)(A + (size_t)row0 * lda + kch0 * 64), (const char*)(Bt + (size_t)col0 * ldb + kch0 * 64), va, vb, nc);
        pre(acc, row0, col0, fr, fq);
#pragma unroll
        for (int m = 0; m < 4; ++m)
#pragma unroll
            for (int n = 0; n < 4; ++n) red[(w * 16 + m * 4 + n) * 64 + lane] = acc[m][n];
        __syncthreads();
#pragma unroll
        for (int i = 0; i < 2; ++i) { const int f = tid + 512 * i; f32x4 s = red[f];
#pragma unroll
            for (int ww = 1; ww < 8; ++ww) s += red[ww * 1024 + f];
            const int tl = f >> 6, ln = f & 63; fin(row0 + 16 * (tl >> 2) + (ln & 15), col0 + 16 * (tl & 3) + 4 * (ln >> 4), s); }
        __syncthreads();
    }
}

__device__ __forceinline__ float dpp_ror1(float v) { return __int_as_float(__builtin_amdgcn_mov_dpp(__float_as_int(v), 0x121, 0xF, 0xF, false)); }
__device__ __forceinline__ float dpp_ror2(float v) { return __int_as_float(__builtin_amdgcn_mov_dpp(__float_as_int(v), 0x122, 0xF, 0xF, false)); }
__device__ __forceinline__ float dpp_shr1(float old, float v) { return __int_as_float(__builtin_amdgcn_update_dpp(__float_as_int(old), __float_as_int(v), 0x111, 0xF, 0xF, false)); }
__device__ __forceinline__ float dpp_shr2(float old, float v) { return __int_as_float(__builtin_amdgcn_update_dpp(__float_as_int(old), __float_as_int(v), 0x112, 0xF, 0xF, false)); }
__device__ __forceinline__ f32x2 gelu2(f32x2 v) {
    const f32x2 av = {fabsf(v[0]), fabsf(v[1])}, rl = {fmaxf(v[0], 0.f), fmaxf(v[1], 0.f)};
    const f32x2 d = av * 0.2316418882f + 1.0f;
    const f32x2 t = {__builtin_amdgcn_rcpf(d[0]), __builtin_amdgcn_rcpf(d[1])};
    f32x2 q = t * 0.5307027145f + (-0.7265760135f); q = q * t + 0.7107068705f; q = q * t + (-0.142248368f); q = q * t + 0.127414796f; q = q * t;
    const f32x2 ea = (v * v) * (-0.72134752044f);
    const f32x2 e = {__builtin_amdgcn_exp2f(ea[0]), __builtin_amdgcn_exp2f(ea[1])};
    return rl - av * (q * e);
}
struct EpiConv {
    static constexpr bool PERM = true, HOOK = false;
    bf16_t* U; bf16_t* side; const float* cw; const float* cb;
    __device__ __forceinline__ void operator()(const f32x4 (&acc)[2][2][4][2], const Unit& u, int wr, int wc, int, int) const {
        const int ln_ = lane_id_v(); const int fr = ln_ & 15, fq = ln_ >> 4;
        const int row0 = u.pm * 256 + wr * 64 + fr, f0 = u.pn * 128 + wc * 32 + 8 * fq;
        const bool samp = u.pm * 256 >= MP;
        f32x2 w0[4], w1[4], w2[4], bb[4];
        { const f32x4 a0 = *(const f32x4*)(cw + f0), a1 = *(const f32x4*)(cw + f0 + 4), b0 = *(const f32x4*)(cw + DFF + f0), b1 = *(const f32x4*)(cw + DFF + f0 + 4);
          const f32x4 c0 = *(const f32x4*)(cw + 2 * DFF + f0), c1 = *(const f32x4*)(cw + 2 * DFF + f0 + 4), d0 = *(const f32x4*)(cb + f0), d1 = *(const f32x4*)(cb + f0 + 4);
          w0[0] = (f32x2){a0[0], a0[1]}; w0[1] = (f32x2){a0[2], a0[3]}; w0[2] = (f32x2){a1[0], a1[1]}; w0[3] = (f32x2){a1[2], a1[3]};
          w1[0] = (f32x2){b0[0], b0[1]}; w1[1] = (f32x2){b0[2], b0[3]}; w1[2] = (f32x2){b1[0], b1[1]}; w1[3] = (f32x2){b1[2], b1[3]};
          w2[0] = (f32x2){c0[0], c0[1]}; w2[1] = (f32x2){c0[2], c0[3]}; w2[2] = (f32x2){c1[0], c1[1]}; w2[3] = (f32x2){c1[2], c1[3]};
          bb[0] = (f32x2){d0[0], d0[1]}; bb[1] = (f32x2){d0[2], d0[3]}; bb[2] = (f32x2){d1[0], d1[1]}; bb[3] = (f32x2){d1[2], d1[3]}; }
#pragma unroll
        for (int ai = 0; ai < 2; ++ai) {
            float p1[8], p2[8];
#pragma unroll
            for (int j = 0; j < 8; ++j) { p1[j] = 0.f; p2[j] = 0.f; }
#pragma unroll
            for (int m = 0; m < 4; ++m) { const int r = row0 + ai * 128 + m * 16;
                float a[8], b[8], am1[8], am2[8];
#pragma unroll
                for (int j = 0; j < 4; ++j) { a[j] = acc[ai][0][m][0][j]; a[4 + j] = acc[ai][0][m][1][j]; b[j] = acc[ai][1][m][0][j]; b[4 + j] = acc[ai][1][m][1][j]; }
#pragma unroll
                for (int j = 0; j < 8; ++j) { am1[j] = dpp_shr1(p1[j], a[j]); am2[j] = dpp_shr2(p2[j], a[j]); }
                if (m < 3) {
#pragma unroll
                    for (int j = 0; j < 8; ++j) { p1[j] = dpp_ror1(a[j]); p2[j] = dpp_ror2(a[j]); } }
                u32x4 w;
#pragma unroll
                for (int jp = 0; jp < 4; ++jp) { const f32x2 A = {a[2 * jp], a[2 * jp + 1]}, A1 = {am1[2 * jp], am1[2 * jp + 1]}, A2 = {am2[2 * jp], am2[2 * jp + 1]}, B = {b[2 * jp], b[2 * jp + 1]};
                    const f32x2 pre = bb[jp] + A2 * w0[jp] + A1 * w1[jp] + A * w2[jp];
                    const f32x2 g = gelu2(pre) * B; w[jp] = cvt_pk_bf16(g[0], g[1]); }
                *(u32x4*)(U + (size_t)r * DFF + f0) = w;
                const bool first = samp || m == 0, lastg = samp || m == 3;
                if ((first && fr < 2) || (lastg && fr >= 14)) { bf16_t* sp = side + (size_t)(r >> 4) * 6 * DFF + f0;
                    u32x4 wa; wa.x = cvt_pk_bf16(a[0], a[1]); wa.y = cvt_pk_bf16(a[2], a[3]); wa.z = cvt_pk_bf16(a[4], a[5]); wa.w = cvt_pk_bf16(a[6], a[7]);
                    if (first && fr < 2) { u32x4 wb; wb.x = cvt_pk_bf16(b[0], b[1]); wb.y = cvt_pk_bf16(b[2], b[3]); wb.z = cvt_pk_bf16(b[4], b[5]); wb.w = cvt_pk_bf16(b[6], b[7]);
                        *(u32x4*)(sp + (size_t)fr * DFF) = wa; *(u32x4*)(sp + (size_t)(2 + fr) * DFF) = wb; }
                    if (lastg && fr >= 14) *(u32x4*)(sp + (size_t)(4 + fr - 14) * DFF) = wa; }
            }
        }
    }
    __device__ __forceinline__ void hook(f32x4 (&)[2][2][4][2], const Unit&, int, int, int, int, int) const {}
};

constexpr int AT_KBUF = 25600, AT_VBUF0 = 51200, AT_VBYTES = 17408, AT_BIAS = 86016, AT_VSTR = 136;
__device__ __forceinline__ f32x16 mfma32(bf16x8 a, bf16x8 b, f32x16 c) { return __builtin_amdgcn_mfma_f32_32x32x16_bf16(a, b, c, 0, 0, 0); }
__device__ __forceinline__ float xhalf_max(float v) { auto rr = __builtin_amdgcn_permlane32_swap(__float_as_uint(v), __float_as_uint(v), false, false); return fmaxf(__uint_as_float(rr[0]), __uint_as_float(rr[1])); }
__device__ __forceinline__ float xhalf_sum(float v) { auto rr = __builtin_amdgcn_permlane32_swap(__float_as_uint(v), __float_as_uint(v), false, false); return __uint_as_float(rr[0]) + __uint_as_float(rr[1]); }
__device__ __forceinline__ bf16x8 pack8f(const f32x16& p, int base) {
    u32x4 w; w.x = cvt_pk_bf16(p[base + 0], p[base + 1]); w.y = cvt_pk_bf16(p[base + 2], p[base + 3]); w.z = cvt_pk_bf16(p[base + 4], p[base + 5]); w.w = cvt_pk_bf16(p[base + 6], p[base + 7]);
    return *reinterpret_cast<bf16x8*>(&w);
}

struct MlaLoader {
    unsigned tid; const char* kn; const char* kr; const char* vt; int nkeys;
    u32x4 rk[3], rv[2];
    __device__ __forceinline__ void load(int t) {
        unsigned tid = this->tid; asm volatile("" : "+v"(tid));
        const char* knt = kn + (size_t)t * (64 * 2048); const char* krt = kr + (size_t)t * (64 * 128); const char* vtt = vt + (size_t)t * 128;
#pragma unroll
        for (int i = 0; i < 2; ++i) { const unsigned c = tid + 512u * i; rk[i] = *(const u32x4*)(knt + ((c >> 4) * 2048u + (c & 15u) * 16u)); }
        rk[2] = *(const u32x4*)(krt + ((tid >> 3) * 128u + (tid & 7u) * 16u));
#pragma unroll
        for (int i = 0; i < 2; ++i) { const unsigned c = tid + 512u * i; rv[i] = *(const u32x4*)(vtt + ((c >> 3) * (unsigned)(VT_LD * 2) + (c & 7u) * 16u)); }
        if ((t + 1) * 64 > nkeys) {
#pragma unroll
            for (int i = 0; i < 2; ++i) { const unsigned c = tid + 512u * i; if (t * 64 + (int)(c & 7u) * 8 >= nkeys) rv[i] = (u32x4){0u, 0u, 0u, 0u}; } }
    }
    __device__ __forceinline__ void store(LAS unsigned char* kb, LAS unsigned char* vb) const {
        unsigned tid = this->tid; asm volatile("" : "+v"(tid));
#pragma unroll
        for (int i = 0; i < 2; ++i) { const unsigned c = tid + 512u * i; *(LAS u32x4*)(kb + (c >> 4) * 400u + (c & 15u) * 16u) = rk[i]; }
        *(LAS u32x4*)(kb + (tid >> 3) * 400u + 256u + (tid & 7u) * 16u) = rk[2];
#pragma unroll
        for (int i = 0; i < 2; ++i) { const unsigned c = tid + 512u * i; LAS unsigned char* d = vb + (c >> 3) * (unsigned)AT_VSTR + (c & 7u) * 16u;
            *(LAS u32x2*)d = (u32x2){rv[i].x, rv[i].y}; *(LAS u32x2*)(d + 8) = (u32x2){rv[i].z, rv[i].w}; }
    }
};
struct BandLoader {
    unsigned tid; const char* kc; const char* vc; int ncache;
    const char* kp; const char* vp; int nkeys;
    u32x4 rk[2], rv[2];
    __device__ __forceinline__ void load(int t) {
        unsigned tid = this->tid; asm volatile("" : "+v"(tid));
        const unsigned kpair = tid & 31u, vpart = tid >> 5;
        if (t * 64 < ncache) {
            const char* kt = kc + (size_t)t * (64 * 4096); const char* vtt = vc + (size_t)t * (64 * 4096);
#pragma unroll
            for (int i = 0; i < 2; ++i) { const unsigned c = tid + 512u * i; const char* s = kt + ((c >> 4) * 4096u + (c & 15u) * 32u); const f32x4 a = *(const f32x4*)s, b = *(const f32x4*)(s + 16);
                rk[i] = (u32x4){cvt_pk_bf16(a[0], a[1]), cvt_pk_bf16(a[2], a[3]), cvt_pk_bf16(b[0], b[1]), cvt_pk_bf16(b[2], b[3])}; }
#pragma unroll
            for (int i = 0; i < 2; ++i) { const char* s = vtt + ((2u * kpair + i) * 4096u + vpart * 32u); const f32x4 a = *(const f32x4*)s, b = *(const f32x4*)(s + 16);
                rv[i] = (u32x4){cvt_pk_bf16(a[0], a[1]), cvt_pk_bf16(a[2], a[3]), cvt_pk_bf16(b[0], b[1]), cvt_pk_bf16(b[2], b[3])}; }
        } else {
            const int k0 = t * 64 - ncache; const char* kt = kp + (size_t)k0 * (NPROJ * 2); const char* vtt = vp + (size_t)k0 * (NPROJ * 2);
#pragma unroll
            for (int i = 0; i < 2; ++i) { const unsigned c = tid + 512u * i; rk[i] = *(const u32x4*)(kt + ((c >> 4) * (unsigned)(NPROJ * 2) + (c & 15u) * 16u)); }
#pragma unroll
            for (int i = 0; i < 2; ++i) rv[i] = *(const u32x4*)(vtt + ((2u * kpair + i) * (unsigned)(NPROJ * 2) + vpart * 16u));
            if ((t + 1) * 64 > nkeys) {
#pragma unroll
                for (int i = 0; i < 2; ++i) if (t * 64 + (int)(2u * kpair) + i >= nkeys) rv[i] = (u32x4){0u, 0u, 0u, 0u}; }
        }
    }
    __device__ __forceinline__ void store(LAS unsigned char* kb, LAS unsigned char* vb) const {
        unsigned tid = this->tid; asm volatile("" : "+v"(tid));
#pragma unroll
        for (int i = 0; i < 2; ++i) { const unsigned c = tid + 512u * i; *(LAS u32x4*)(kb + (c >> 4) * 272u + (c & 15u) * 16u) = rk[i]; }
        const unsigned kpair = tid & 31u, part = tid >> 5; LAS unsigned char* d = vb + (part * 8u) * (unsigned)AT_VSTR + kpair * 4u;
        const unsigned a[4] = {rv[0].x, rv[0].y, rv[0].z, rv[0].w}, b[4] = {rv[1].x, rv[1].y, rv[1].z, rv[1].w};
#pragma unroll
        for (int e = 0; e < 4; ++e) { *(LAS unsigned*)(d + (2 * e) * AT_VSTR) = (a[e] & 0xffffu) | (b[e] << 16); *(LAS unsigned*)(d + (2 * e + 1) * AT_VSTR) = (a[e] >> 16) | (b[e] & 0xffff0000u); }
    }
};

template <int DQK, bool BIAS, class Loader>
__device__ __forceinline__ void attn_unit(const int tid, LAS unsigned char* lds, Loader& L, const bf16_t* qptr, bool wave_active, int t0, int t1, int wt0, int wt1, int nkeys, int qpos, int kpos0, bf16_t* optr) {
    constexpr int NKS = DQK / 16, KSTR = DQK * 2 + 16;
    const int lane = tid & 63, l31 = lane & 31, hi = lane >> 5;
    bf16x8 qf[NKS];
#pragma unroll
    for (int ks = 0; ks < NKS; ++ks) qf[ks] = *(const bf16x8*)(qptr + ks * 16 + hi * 8);
    f32x16 o0, o1, o2, o3;
#pragma unroll
    for (int r = 0; r < 16; ++r) { o0[r] = 0.f; o1[r] = 0.f; o2[r] = 0.f; o3[r] = 0.f; }
    float m_run = -1e30f, l_run = 0.f;
    L.load(t0); L.store(lds, lds + AT_VBUF0); if (t0 + 1 < t1) L.load(t0 + 1); __syncthreads();
    for (int t = t0; t < t1; ++t) {
        const int cur = (t - t0) & 1;
        if (t + 1 < t1) L.store(lds + (cur ^ 1) * AT_KBUF, lds + AT_VBUF0 + (cur ^ 1) * AT_VBYTES);
        if (t + 2 < t1) L.load(t + 2);
        if (wave_active && t >= wt0 && t < wt1) {
            const LAS unsigned char* kb = lds + cur * AT_KBUF + l31 * KSTR + hi * 16;
            const LAS unsigned char* vb = lds + AT_VBUF0 + cur * AT_VBYTES + l31 * AT_VSTR + hi * 8;
            f32x16 sv[2];
#pragma unroll
            for (int r = 0; r < 16; ++r) { sv[0][r] = 0.f; sv[1][r] = 0.f; }
            constexpr int KG = (DQK == 192 ? 6 : 4), NG2 = 2 * NKS / KG;
            bf16x8 kfa[KG], kfb[KG];
#define AT_LDK(dst, g) { _Pragma("unroll") for (int j_ = 0; j_ < KG; ++j_) { const int idx_ = (g) * KG + j_, kh_ = idx_ / NKS, ks_ = idx_ % NKS; dst[j_] = *(const LAS bf16x8*)(kb + kh_ * 32 * KSTR + ks_ * 32); } }
#define AT_MMK(src, g) { __builtin_amdgcn_s_setprio(1); _Pragma("unroll") for (int j_ = 0; j_ < KG; ++j_) { const int idx_ = (g) * KG + j_, kh_ = idx_ / NKS, ks_ = idx_ % NKS; sv[kh_] = mfma32(src[j_], qf[ks_], sv[kh_]); } __builtin_amdgcn_s_setprio(0); }
            AT_LDK(kfa, 0)
#pragma unroll
            for (int g = 0; g < NG2; g += 2) {
                if (g + 1 < NG2) AT_LDK(kfb, g + 1)
                __builtin_amdgcn_sched_barrier(0);
                AT_MMK(kfa, g)
                __builtin_amdgcn_sched_barrier(0);
                if (g + 2 < NG2) AT_LDK(kfa, g + 2)
                __builtin_amdgcn_sched_barrier(0);
                if (g + 1 < NG2) AT_MMK(kfb, g + 1)
                __builtin_amdgcn_sched_barrier(0);
            }
#undef AT_LDK
#undef AT_MMK
            bf16x8 vfa[4], vfb[4];
#define AT_LDV(dst, s_) { _Pragma("unroll") for (int db_ = 0; db_ < 4; ++db_) { const u32x2 a_ = *(const LAS u32x2*)(vb + db_ * 32 * AT_VSTR + (s_) * 32), b_ = *(const LAS u32x2*)(vb + db_ * 32 * AT_VSTR + (s_) * 32 + 16); u32x4 w_ = {a_.x, a_.y, b_.x, b_.y}; dst[db_] = *reinterpret_cast<bf16x8*>(&w_); } }
#define AT_MMV(src, pf_) { __builtin_amdgcn_s_setprio(1); o0 = mfma32(src[0], pf_, o0); o1 = mfma32(src[1], pf_, o1); o2 = mfma32(src[2], pf_, o2); o3 = mfma32(src[3], pf_, o3); __builtin_amdgcn_s_setprio(0); }
            AT_LDV(vfa, 0)
#pragma unroll
            for (int kh = 0; kh < 2; ++kh) {
                f32x16& s = sv[kh];
                if (BIAS) { const LAS float* bt = (const LAS float*)(lds + AT_BIAS); const int d0 = qpos - (kpos0 + t * 64 + kh * 32) - 4 * hi;
                    if (__builtin_amdgcn_readfirstlane(qpos) - (kpos0 + t * 64 + kh * 32 + 31) >= 128) { const float bc = bt[256];
#pragma unroll
                        for (int r = 0; r < 16; ++r) s[r] += bc; }
                    else {
#pragma unroll
                        for (int r = 0; r < 16; ++r) { const int c = (r & 3) + 8 * (r >> 2); int da = d0 - c; da = (da < -128 ? -128 : (da > 128 ? 128 : da)) + 128; s[r] += bt[da]; } } }
                if ((t + 1) * 64 > nkeys) { const int kb0 = t * 64 + kh * 32 + 4 * hi; const float NEG = -__builtin_inff();
#pragma unroll
                    for (int r = 0; r < 16; ++r) { const int c = (r & 3) + 8 * (r >> 2); if (kb0 + c >= nkeys) s[r] = NEG; } }
                float pmax = s[0];
#pragma unroll
                for (int r = 1; r < 16; ++r) pmax = fmaxf(pmax, s[r]);
                pmax = xhalf_max(pmax);
                if (!__all((pmax - m_run) <= 8.0f)) { const float mn = fmaxf(m_run, pmax), alpha = __builtin_amdgcn_exp2f(m_run - mn); m_run = mn; l_run *= alpha;
#pragma unroll
                    for (int r = 0; r < 16; ++r) { o0[r] *= alpha; o1[r] *= alpha; o2[r] *= alpha; o3[r] *= alpha; } }
                float ps = 0.f;
#pragma unroll
                for (int r = 0; r < 16; ++r) { s[r] = __builtin_amdgcn_exp2f(s[r] - m_run); ps += s[r]; }
                l_run += xhalf_sum(ps);
                const bf16x8 pf0 = pack8f(s, 0), pf1 = pack8f(s, 8);
                __builtin_amdgcn_sched_barrier(0);
                AT_LDV(vfb, kh * 2 + 1)
                __builtin_amdgcn_sched_barrier(0);
                AT_MMV(vfa, pf0)
                __builtin_amdgcn_sched_barrier(0);
                if (kh == 0) AT_LDV(vfa, 2)
                __builtin_amdgcn_sched_barrier(0);
                AT_MMV(vfb, pf1)
                __builtin_amdgcn_sched_barrier(0);
            }
#undef AT_LDV
#undef AT_MMV
        }
        __syncthreads();
    }
    if (optr) { const float inv = 1.0f / l_run;
#pragma unroll
        for (int g = 0; g < 4; ++g) { bf16_t* p = optr + 8 * g + 4 * hi;
            *(u32x2*)(p)      = (u32x2){cvt_pk_bf16(o0[4 * g] * inv, o0[4 * g + 1] * inv), cvt_pk_bf16(o0[4 * g + 2] * inv, o0[4 * g + 3] * inv)};
            *(u32x2*)(p + 32) = (u32x2){cvt_pk_bf16(o1[4 * g] * inv, o1[4 * g + 1] * inv), cvt_pk_bf16(o1[4 * g + 2] * inv, o1[4 * g + 3] * inv)};
            *(u32x2*)(p + 64) = (u32x2){cvt_pk_bf16(o2[4 * g] * inv, o2[4 * g + 1] * inv), cvt_pk_bf16(o2[4 * g + 2] * inv, o2[4 * g + 3] * inv)};
            *(u32x2*)(p + 96) = (u32x2){cvt_pk_bf16(o3[4 * g] * inv, o3[4 * g + 1] * inv), cvt_pk_bf16(o3[4 * g + 2] * inv, o3[4 * g + 3] * inv)}; } }
}

constexpr int RT_Q = 0, RT_K = 9216, RT_V = 18432, RT_RED = 35840, RT_QSTR = 144, RT_VSTR = 272;
constexpr int RT_BUF = 38912;
struct RetRegs { u32x4 k, q, v0, v1; };
__device__ __forceinline__ RetRegs ret_fetch(const int tid, const bf16_t* prow0, int nvalid, int h, bool withq) {
    RetRegs R; unsigned z0 = 0u; asm volatile("" : "+v"(z0)); const u32x4 z = {z0, z0, z0, z0};
    { const int row = tid >> 3, part = tid & 7; const bool ok = row < nvalid; const bf16_t* p = prow0 + (size_t)row * NPROJ + h * 64 + part * 8;
      R.k = ok ? *(const u32x4*)(p + PC_KRR) : z; R.q = (withq && ok) ? *(const u32x4*)(p + PC_QR) : z; }
    { const int row = tid >> 4, part = tid & 15; const bf16_t* p = prow0 + (size_t)row * NPROJ + PC_VR + h * 128 + part * 8;
      R.v0 = row < nvalid ? *(const u32x4*)p : z; R.v1 = (row + 32) < nvalid ? *(const u32x4*)(p + (size_t)32 * NPROJ) : z; }
    return R;
}
__device__ __forceinline__ void ret_put(const int tid, LAS unsigned char* lds, const RetRegs& R, bool withq) {
    { const int row = tid >> 3, part = tid & 7; *(LAS u32x4*)(lds + RT_K + row * RT_QSTR + part * 16) = R.k; if (withq) *(LAS u32x4*)(lds + RT_Q + row * RT_QSTR + part * 16) = R.q; }
    { const int row = tid >> 4, part = tid & 15; *(LAS u32x4*)(lds + RT_V + row * RT_VSTR + part * 16) = R.v0; *(LAS u32x4*)(lds + RT_V + (row + 32) * RT_VSTR + part * 16) = R.v1; }
}
__device__ __forceinline__ void ret_load(const int tid, LAS unsigned char* lds, const bf16_t* prow0, int nvalid, int h, bool withq) { const RetRegs R = ret_fetch(tid, prow0, nvalid, h, withq); ret_put(tid, lds, R, withq); }
__device__ __forceinline__ bf16x8 lds_col8(const LAS unsigned char* base, int stride, const int (&tok)[8]) {
    bf16x8 r;
#pragma unroll
    for (int j = 0; j < 8; ++j) r[j] = (short)*(const LAS unsigned short*)(base + tok[j] * stride);
    return r;
}
__device__ __forceinline__ f32x16 ret_state(const int tid, const LAS unsigned char* lds, int eb, int dbk) {
    const int lane = tid & 63, l31 = lane & 31, hi = lane >> 5;
    f32x16 acc;
#pragma unroll
    for (int r = 0; r < 16; ++r) acc[r] = 0.f;
#pragma unroll
    for (int ks = 0; ks < 4; ++ks) { int tok[8];
#pragma unroll
        for (int j = 0; j < 8; ++j) tok[j] = 16 * ks + 8 * hi + j;
        const bf16x8 a = lds_col8(lds + RT_V + (32 * eb + l31) * 2, RT_VSTR, tok), b = lds_col8(lds + RT_K + (32 * dbk + l31) * 2, RT_QSTR, tok);
        acc = mfma32(a, b, acc); }
    return acc;
}
__device__ __forceinline__ f32x16 ret_out(const int tid, const LAS unsigned char* lds, int eb, int qbk, float ginvL, const bf16x8 (&sf)[4]) {
    const int lane = tid & 63, l31 = lane & 31, hi = lane >> 5;
    bf16x8 qf[4];
#pragma unroll
    for (int ks = 0; ks < 4; ++ks) qf[ks] = *(const LAS bf16x8*)(lds + RT_Q + (32 * qbk + l31) * RT_QSTR + ks * 32 + hi * 16);
    f32x16 s0, s1, acc;
#pragma unroll
    for (int r = 0; r < 16; ++r) { s0[r] = 0.f; s1[r] = 0.f; acc[r] = 0.f; }
#pragma unroll
    for (int ks = 0; ks < 4; ++ks) { const bf16x8 k0 = *(const LAS bf16x8*)(lds + RT_K + l31 * RT_QSTR + ks * 32 + hi * 16), k1 = *(const LAS bf16x8*)(lds + RT_K + (32 + l31) * RT_QSTR + ks * 32 + hi * 16);
        s0 = mfma32(k0, qf[ks], s0); s1 = mfma32(k1, qf[ks], s1); }
    const int qi = 32 * qbk + l31;
#pragma unroll
    for (int r = 0; r < 16; ++r) { const int j = (r & 3) + 8 * (r >> 2) + 4 * hi; s0[r] = (j <= qi) ? s0[r] * ginvL : 0.f; s1[r] = (j + 32 <= qi) ? s1[r] * ginvL : 0.f; }
#pragma unroll
    for (int s = 0; s < 4; ++s) { const bf16x8 pf = pack8f(s < 2 ? s0 : s1, 8 * (s & 1)); int tok[8];
#pragma unroll
        for (int j = 0; j < 8; ++j) tok[j] = 16 * s + 8 * (j >> 2) + 4 * hi + (j & 3);
        const bf16x8 a = lds_col8(lds + RT_V + (32 * eb + l31) * 2, RT_VSTR, tok);
        acc = mfma32(a, pf, acc); }
#pragma unroll
    for (int ks = 0; ks < 4; ++ks) acc = mfma32(sf[ks], qf[ks], acc);
    return acc;
}
__device__ __forceinline__ void ret_finish(LAS unsigned char* lds, const f32x16& acc, int eb, int qbk, const float* grn_h, const bf16_t* gate_row  , bf16_t* out_row  , const int tid) {
    const int lane = tid & 63, l31 = lane & 31, hi = lane >> 5;
    f32x4 gnv[4]; u32x2 gwv[4];
#pragma unroll
    for (int g = 0; g < 4; ++g) { gnv[g] = (f32x4){0.f, 0.f, 0.f, 0.f}; gwv[g] = (u32x2){0u, 0u}; }
    if (out_row) {
#pragma unroll
        for (int g = 0; g < 4; ++g) { const int e0 = 32 * eb + 8 * g + 4 * hi; gnv[g] = *(const f32x4*)(grn_h + e0); gwv[g] = *(const u32x2*)(gate_row + e0); } }
    float ps = 0.f, pq = 0.f;
#pragma unroll
    for (int r = 0; r < 16; ++r) { ps += acc[r]; pq += acc[r] * acc[r]; }
    ps = xhalf_sum(ps); pq = xhalf_sum(pq);
    LAS f32x2* red = (LAS f32x2*)(lds + RT_RED);
    if (hi == 0) red[(qbk * 4 + eb) * 32 + l31] = (f32x2){ps, pq};
    __syncthreads();
    float sum = 0.f, sq = 0.f;
#pragma unroll
    for (int e = 0; e < 4; ++e) { const f32x2 v = red[(qbk * 4 + e) * 32 + l31]; sum += v.x; sq += v.y; }
    const float mean = sum * (1.0f / 128.0f), var = fmaxf(sq * (1.0f / 128.0f) - mean * mean, 0.f), rstd = rsqrtf(var + EPS);
    if (out_row) {
#pragma unroll
        for (int g = 0; g < 4; ++g) { const int e0 = 32 * eb + 8 * g + 4 * hi; const f32x4 gn = gnv[g]; const u32x2 gw = gwv[g];
            const float y0 = (acc[4 * g] - mean) * rstd * gn[0] * bf_lo(gw.x), y1 = (acc[4 * g + 1] - mean) * rstd * gn[1] * bf_hi(gw.x);
            const float y2 = (acc[4 * g + 2] - mean) * rstd * gn[2] * bf_lo(gw.y), y3 = (acc[4 * g + 3] - mean) * rstd * gn[3] * bf_hi(gw.y);
            *(u32x2*)(out_row + e0) = (u32x2){cvt_pk_bf16(y0, y1), cvt_pk_bf16(y2, y3)}; } }
}

constexpr int LDS_MAIN = 131072, LDS_MISC = LDS_MAIN, LDS_BYTES = LDS_MAIN + 1024;

struct Grp { int xr0, nxr, kv0, nkv, b0; bool samp; };
__device__ __forceinline__ Grp make_grp(int g) { Grp r; r.xr0 = g * GPR; r.samp = (g == NG - 1); r.nxr = r.samp ? GXR : GPR; r.kv0 = r.xr0; r.nkv = r.samp ? GKV : GPR; r.b0 = g * GNB; return r; }

__device__ __forceinline__ float wsrc(const float* src, const float* gq, int task, int l, int n, int k) {
    switch (task) {
    case 0: { int sc;
        if (n < 768) sc = n;
        else if (n < 832) { const int p = n - 768; sc = 768 + (p & 1) * 32 + (p >> 1); }
        else if (n < 1024) return 0.f;
        else if (n >= PC_QR && n < PC_VR) { const int q = n - PC_QR, hh = q >> 6, p = q & 63; sc = (PC_QR - 192) + (hh << 6) + (p & 1) * 32 + (p >> 1); }
        else sc = n - 192;
        return src[((size_t)l * 2048 + k) * NIN_SRC + sc]; }
    case 1: { const int hh = n / 192, j = n % 192; const int sc = j < 128 ? n : hh * 192 + 128 + ((j - 128) & 1) * 32 + ((j - 128) >> 1);
        return gq[l * 512 + k] * src[((size_t)l * 512 + k) * 1536 + sc]; }
    case 2: return src[((size_t)l * 256 + k) * 2048 + (n >> 7) * 256 + (n & 127)];
    case 3: return src[((size_t)l * 256 + k) * 2048 + (n >> 7) * 256 + 128 + (n & 127)];
    case 4: { const int kk = k & 1023; return src[((size_t)l * 1024 + kk) * 2048 + n]; }
    case 5: return src[((size_t)l * 2048 + k) * 2048 + n];
    case 6: return src[((size_t)l * 2048 + k) * DFF + (n >> 8) * 128 + (n & 127)];
    default: return src[((size_t)l * DFF + k) * 2048 + n];
    }
}
constexpr int WC_TILES = 6656 + 192 + 64 + 64 + 1536 + 1024 + 5632 + 2816;
struct WcTile { int task, K, n0, k0, srci; size_t dst; };
__device__ __forceinline__ WcTile wconv_decode(int u) {
    WcTile t; int rem = u;
    if (rem < 6656) { t.task = 0; t.K = 2048; t.dst = WT_IN; }
    else if ((rem -= 6656) < 192) { t.task = 1; t.K = 512; t.dst = WT_UQ; }
    else if ((rem -= 192) < 64) { t.task = 2; t.K = 256; t.dst = WT_UK; }
    else if ((rem -= 64) < 64) { t.task = 3; t.K = 256; t.dst = WT_UV; }
    else if ((rem -= 64) < 1536) { t.task = 4; t.K = 3072; t.dst = WT_P; }
    else if ((rem -= 1536) < 1024) { t.task = 5; t.K = 2048; t.dst = WT_O; }
    else if ((rem -= 1024) < 5632) { t.task = 6; t.K = 2048; t.dst = WT_FAB; }
    else { rem -= 5632; t.task = 7; t.K = DFF; t.dst = WT_FD; }
    const int ktiles = t.K >> 6; t.n0 = (rem / ktiles) * 64; t.k0 = (rem % ktiles) * 64;
    t.srci = t.task == 0 ? 12 : t.task == 1 ? 15 : t.task < 4 ? 16 : t.task == 4 ? 19 + (t.k0 >> 10) : t.task == 5 ? 22 : t.task == 6 ? ((t.n0 & 255) < 128 ? 25 : 26) : 29;
    return t;
}
__device__ __forceinline__ void wconv_units(const int tid, const PT& pt, unsigned char* ws, LAS unsigned char* lds, int l, int first, int stride) {
    bf16_t* wt = (bf16_t*)(ws + WS_WT);
    const int lane = tid & 63, w = __builtin_amdgcn_readfirstlane(tid >> 6);
    LAS unsigned char* wl = lds + w * 8704;
    const float* gq = pt.in(13);
#define WC_LOAD(V, T) do { const float* src_ = pt.in((T).srci); _Pragma("unroll") for (int j = 0; j < 64; ++j) V[j] = wsrc(src_, gq, (T).task, l, (T).n0 + lane, (T).k0 + j); } while (0)
#define WC_STORE(V, T) do { _Pragma("unroll") for (int j = 0; j < 32; ++j) *(LAS unsigned*)(wl + lane * 136 + j * 4) = cvt_pk_bf16(V[2 * j], V[2 * j + 1]); \
        asm volatile("s_waitcnt lgkmcnt(0)" ::: "memory"); \
        _Pragma("unroll") for (int i = 0; i < 4; ++i) { const int n = (lane >> 2) + 16 * i, kq = lane & 3; const LAS unsigned char* p = wl + n * 136 + kq * 32; \
            const u32x2 a0 = *(const LAS u32x2*)p, a1 = *(const LAS u32x2*)(p + 8), a2 = *(const LAS u32x2*)(p + 16), a3 = *(const LAS u32x2*)(p + 24); \
            bf16_t* d = wt + (T).dst + (size_t)((T).n0 + n) * (T).K + (T).k0 + kq * 16; \
            *(u32x4*)d = (u32x4){a0.x, a0.y, a1.x, a1.y}; *(u32x4*)(d + 8) = (u32x4){a2.x, a2.y, a3.x, a3.y}; } \
        asm volatile("s_waitcnt lgkmcnt(0)" ::: "memory"); } while (0)
    for (int u = first + w; u < WC_TILES; u += 2 * stride) {
        const int u2 = u + stride; const bool two = u2 < WC_TILES;
        const WcTile ta = wconv_decode(u), tb = wconv_decode(two ? u2 : u);
        float va[64], vb[64];
        WC_LOAD(va, ta); WC_LOAD(vb, tb);
        WC_STORE(va, ta);
        if (two) WC_STORE(vb, tb);
    }
#undef WC_LOAD
#undef WC_STORE
}

__global__ void __launch_bounds__(512, 2) hse_fwd(Params P) {
    extern __shared__ __attribute__((aligned(16))) unsigned char shm[];
    LAS unsigned char* lds = (LAS unsigned char*)shm;
    const int wave_s = __builtin_amdgcn_readfirstlane(threadIdx.x >> 6);
    const int tid = threadIdx.x;
    const int G = gridDim.x, bid = blockIdx.x;
    volatile LAS unsigned* misc = (volatile LAS unsigned*)(lds + LDS_MISC);
    PT pt; pt.t = (LAS unsigned long long*)(lds + LDS_MISC + 64);
    if (tid < 4) misc[tid] = 0u;
    if (tid == 0) {
#pragma unroll
        for (int i = 0; i < 32; ++i) pt.t[i] = (unsigned long long)P.in[i];
        pt.t[32] = (unsigned long long)P.out; pt.t[33] = (unsigned long long)P.ws;
    }
    __syncthreads();
    const int lo = P.ph_lo, hi_all = P.ph_hi;
    XcdBarrier bar; bar.bar = (unsigned*)(P.ws + WS_CTL); bar.x = 0; bar.st = misc;
    if (hi_all - lo > 1) bar = xcd_barrier_post((unsigned*)(P.ws + WS_CTL), misc);
    { const int hi = hi_all;
    int ph = 0;
#define PH_BEGIN(k) if (lo <= ph && ph < hi) { __syncthreads(); const int tid = opaque_tid(wave_s); const int lane = tid & 63; const int wave = __builtin_amdgcn_readfirstlane(tid >> 6); (void)lane; (void)wave; unsigned char* const ws = (unsigned char*)pt.in(33); float* const out = (float*)pt.in(32); (void)out;
#define PH_END   if (ph + 1 < hi) { bar.bar = (unsigned*)((unsigned char*)pt.in(33) + WS_CTL); xcd_barrier(bar, opaque_tid(wave_s)); } } ++ph;
#define INP(k) pt.in(k)
#define ada    ((float*)(ws + WS_ADA))
#define rope   ((float*)(ws + WS_ROPE))
#define sqv    ((float*)(ws + WS_SQ))
#define wt     ((bf16_t*)(ws + WS_WT))
#define hbuf   ((bf16_t*)(ws + WS_H))
#define xbuf   ((bf16_t*)(ws + WS_XB))
#define proj   ((bf16_t*)(ws + WB_PROJ))
#define gatebuf ((bf16_t*)(ws + WB_GATE))
#define qbuf   ((bf16_t*)(ws + WB_Q))
#define ckva   ((bf16_t*)(ws + WB_CKV))
#define kropa  ((bf16_t*)(ws + WB_KROPE))
#define knope  ((bf16_t*)(ws + WB_KNOPE))
#define vtb    ((bf16_t*)(ws + WB_VT))
#define ocat   ((bf16_t*)(ws + WB_OCAT))
#define merged ((bf16_t*)(ws + WB_MERGED))
#define rets   ((bf16_t*)(ws + WB_RETS))
#define retb   ((bf16_t*)(ws + WB_RETB))
#define ubuf   ((bf16_t*)(ws + WF_U))
#define sidebuf ((bf16_t*)(ws + WF_SIDE))

    PH_BEGIN(0)
    {
        constexpr int NU = 2 * (NADA / 32), SST = 52, SBUF = 256 * SST;
        LAS float* sl = (LAS float*)lds;
        const int fi = lane & 15, fk = lane >> 4, kq = tid & 255, sh = wave >> 2;
        const float* const cP = INP(2); const float* const cS = INP(3);
        for (int u0 = bid; u0 < NU; u0 += 3 * G) {
            const float* wb[3]; int ul[3], un0[3]; bool uok[3];
#pragma unroll
            for (int i = 0; i < 3; ++i) { const int uu = u0 + i * G; uok[i] = uu < NU; const int u = uok[i] ? uu : u0; ul[i] = u / (NADA / 32); un0[i] = (u % (NADA / 32)) * 32; wb[i] = INP(10) + (size_t)ul[i] * DM * NADA + un0[i]; }
            f32x4 acc[3][2][3];
#pragma unroll
            for (int i = 0; i < 3; ++i)
#pragma unroll
                for (int nt = 0; nt < 2; ++nt)
#pragma unroll
                    for (int jt = 0; jt < 3; ++jt) acc[i][nt][jt] = (f32x4){0.f, 0.f, 0.f, 0.f};
            const unsigned voffb = (unsigned)((32 * wave + fk) * NADA + fi) * 4u, kqb = (unsigned)kq * 4u;
            float wf[2][3][2][8], cv[18];
#define ADA_LDW(bu, c_) do { unsigned vo_ = voffb; asm volatile("" : "+v"(vo_)); _Pragma("unroll") for (int i_ = 0; i_ < 3; ++i_) _Pragma("unroll") for (int nt_ = 0; nt_ < 2; ++nt_) _Pragma("unroll") for (int ks_ = 0; ks_ < 8; ++ks_) \
                wf[bu][i_][nt_][ks_] = *(const float*)((const char*)(wb[i_] + (size_t)((256 * (c_) + 4 * ks_) * NADA + 16 * nt_)) + vo_); } while (0)
#define ADA_LDC(c_) do { unsigned ko_ = kqb; asm volatile("" : "+v"(ko_)); _Pragma("unroll") for (int q_ = 0; q_ < 18; ++q_) { const int s_ = 18 * sh + q_; const float* cp_ = s_ < NB ? cP + s_ * DM : cS + (s_ - NB) * DM; cv[q_] = *(const float*)((const char*)(cp_ + 256 * (c_)) + ko_); } } while (0)
#define ADA_FILL(bp) do { _Pragma("unroll") for (int q_ = 0; q_ < 18; ++q_) { const float v_ = cv[q_]; (bp)[kq * SST + 18 * sh + q_] = v_ * sigmoidf_(v_); } } while (0)
#define ADA_MM(bu, bp) do { _Pragma("unroll") for (int ks_ = 0; ks_ < 8; ++ks_) { float sf_[3]; _Pragma("unroll") for (int jt_ = 0; jt_ < 3; ++jt_) sf_[jt_] = (bp)[(32 * wave + 4 * ks_ + fk) * SST + 16 * jt_ + fi]; \
                _Pragma("unroll") for (int i_ = 0; i_ < 3; ++i_) _Pragma("unroll") for (int nt_ = 0; nt_ < 2; ++nt_) _Pragma("unroll") for (int jt_ = 0; jt_ < 3; ++jt_) \
                    acc[i_][nt_][jt_] = __builtin_amdgcn_mfma_f32_16x16x4f32(wf[bu][i_][nt_][ks_], sf_[jt_], acc[i_][nt_][jt_], 0, 0, 0); } } while (0)
            __syncthreads();
            for (int z = tid; z < 2 * 256 * 12; z += 512) { const int b = z / (256 * 12), r = z % (256 * 12); sl[b * SBUF + (r / 12) * SST + 36 + (r % 12)] = 0.f; }
            ADA_LDC(0); ADA_LDW(0, 0); ADA_FILL(sl); ADA_LDC(1);
            __syncthreads();
#pragma unroll 1
            for (int c = 0; c < 8; c += 2) {
                ADA_LDW(1, c + 1); ADA_FILL(sl + SBUF); if (c + 2 < 8) ADA_LDC(c + 2);
                ADA_MM(0, sl);
                __syncthreads();
                if (c + 2 < 8) { ADA_LDW(0, c + 2); ADA_FILL(sl); ADA_LDC(c + 3); }
                ADA_MM(1, sl + SBUF);
                __syncthreads();
            }
#undef ADA_LDW
#undef ADA_LDC
#undef ADA_FILL
#undef ADA_MM
            LAS f32x4* red = (LAS f32x4*)lds;
#pragma unroll
            for (int i = 0; i < 3; ++i) {
#pragma unroll
                for (int nt = 0; nt < 2; ++nt)
#pragma unroll
                    for (int jt = 0; jt < 3; ++jt) red[(wave * 6 + nt * 3 + jt) * 64 + lane] = acc[i][nt][jt];
                __syncthreads();
                if (tid < 384 && uok[i]) { const int tile = tid >> 6, ln = tid & 63, nt = tile / 3, jt = tile % 3, s = 16 * jt + (ln & 15), n = un0[i] + 16 * nt + 4 * (ln >> 4);
                    f32x4 v = red[tid];
#pragma unroll
                    for (int w = 1; w < 8; ++w) v += red[w * 384 + tid];
                    if (s < NSTREAM) { v += *(const f32x4*)(INP(11) + ul[i] * NADA + n); *(f32x4*)(ada + ((size_t)ul[i] * NSTREAM + s) * NADA + n) = v; } }
                __syncthreads();
            }
        }
        for (int i = bid * 512 + tid; i < TT * 32; i += G * 512) { const int pos = i >> 5, j = i & 31;
            double inv = 1.0; for (int q = 0; q < j; ++q) inv *= 0.7498942093324559;
            const double t = (double)pos * inv; const double qd = __builtin_rint(t * 0.6366197723675814); const double r = (t - qd * 1.5707963267948966) - qd * 6.123233995736766e-17;
            const double r2 = r * r;
            double sn = r * (1.0 + r2 * (-1.0 / 6 + r2 * (1.0 / 120 + r2 * (-1.0 / 5040 + r2 * (1.0 / 362880 + r2 * (-1.0 / 39916800 + r2 * (1.0 / 6227020800.0)))))));
            double cs = 1.0 + r2 * (-0.5 + r2 * (1.0 / 24 + r2 * (-1.0 / 720 + r2 * (1.0 / 40320 + r2 * (-1.0 / 3628800 + r2 * (1.0 / 479001600.0 + r2 * (-1.0 / 87178291200.0)))))));
            const int qi = (int)((long long)qd & 3); double c2, s2;
            if (qi == 0) { c2 = cs; s2 = sn; } else if (qi == 1) { c2 = -sn; s2 = cs; } else if (qi == 2) { c2 = -cs; s2 = -sn; } else { c2 = sn; s2 = -cs; }
            *(f32x2*)(rope + (size_t)i * 2) = (f32x2){(float)c2, (float)s2}; }
        __syncthreads();
        wconv_units(tid, pt, ws, lds, 0, ((bid + 128) % G) * 8, G * 8);
    }
    PH_END

    PH_BEGIN(1)
    { f32x4 hv[2][2], cv[2][2]; int cst[2] = {-1, -1};
#pragma unroll
      for (int e = 0; e < 2; ++e) { hv[e][0] = (f32x4){0.f, 0.f, 0.f, 0.f}; hv[e][1] = hv[e][0]; cv[e][0] = hv[e][0]; cv[e][1] = hv[e][0]; }
      for (size_t it = (size_t)bid * 512 + tid; it < (size_t)MX * 256; it += (size_t)G * 1024) {
        const size_t it2 = it + (size_t)G * 512; const bool two = it2 < (size_t)MX * 256; const size_t itb = two ? it2 : it;
        f32x4 xv[2][2];
#pragma unroll
        for (int e = 0; e < 2; ++e) { const size_t ii = e ? itb : it; const int ar = (int)(ii >> 8), c = (int)(ii & 255) * 8;
            const float* x = (ar < MP ? INP(0) + (size_t)ar * DM : INP(1) + (size_t)(ar - MP) * DM) + c;
            xv[e][0] = *(const f32x4*)x; xv[e][1] = *(const f32x4*)(x + 4);
            const int st = row_stream(ar);
            if (st != cst[e]) { cst[e] = st; const float* a = ada + (size_t)st * NADA + c; hv[e][0] = *(const f32x4*)a; hv[e][1] = *(const f32x4*)(a + 4); cv[e][0] = *(const f32x4*)(a + DM); cv[e][1] = *(const f32x4*)(a + DM + 4); } }
#pragma unroll
        for (int e = 0; e < 2; ++e) { if (e == 1 && !two) break; const size_t ii = e ? itb : it; const int ar = (int)(ii >> 8), c = (int)(ii & 255) * 8;
            const f32x4 y0 = xv[e][0] * (cv[e][0] + 1.0f) + hv[e][0], y1 = xv[e][1] * (cv[e][1] + 1.0f) + hv[e][1];
            u32x4 w; w.x = cvt_pk_bf16(y0[0], y0[1]); w.y = cvt_pk_bf16(y0[2], y0[3]); w.z = cvt_pk_bf16(y1[0], y1[1]); w.w = cvt_pk_bf16(y1[2], y1[3]);
            *(u32x4*)(hbuf + (size_t)ar * DM + c) = w; } } }
    PH_END

#pragma unroll 1
    for (int l = 0; l < 2; ++l) {
#define adal (ada + (size_t)l * NSTREAM * NADA)
#pragma unroll 1
        for (int g = 0; g < NG; ++g) {
            const Grp gr = make_grp(g);
            PH_BEGIN(2)
            { pg8::Gemm gm{hbuf + (size_t)gr.xr0 * DM, wt + WT_IN, gr.nxr, NPROJ_ALL, 2048, 2048, 2048}; pg8::StaticOrder S; S.init(gm.M, gm.N, G, bid);
              EpiProj E{proj, gatebuf}; pg8::gemm_phase<EpiProj>(tid, lds, gm, S, E); }
            PH_END

            PH_BEGIN(3)
            { const int njobs = gr.nxr;
              const f32x4 gk = *(const f32x4*)(INP(14) + l * 256 + lane * 4);
              struct RowIn { u32x4 wcq; u32x2 wkv; unsigned wkr; f32x2 csr; u32x4 ba[2], bb[2]; f32x4 t0, t1; u32x4 wq, wk; };
              auto row_load = [&](const int job) __attribute__((always_inline)) -> RowIn { RowIn R;
                    const int rr = job, ar = gr.xr0 + rr, pos = row_pos(ar); const bf16_t* pr = proj + (size_t)rr * NPROJ;
                    const bool isp = ar < MP; const bool bandc = !isp || (ar & (TT - 1)) >= TT - 512;
                    R.wcq = *(const u32x4*)(pr + PC_CQ + lane * 8);
                    R.wkv = *(const u32x2*)(pr + PC_CKV + lane * 4);
                    R.wkr = 0u; R.csr = (f32x2){1.f, 0.f};
                    if (lane < 32) { R.wkr = *(const unsigned*)(pr + PC_KR + 2 * lane); R.csr = *(const f32x2*)(rope + ((size_t)pos * 32 + lane) * 2); }
#pragma unroll
                    for (int i = 0; i < 2; ++i) { R.ba[i] = (u32x4){0u, 0u, 0u, 0u}; R.bb[i] = R.ba[i]; }
                    if (bandc) {
#pragma unroll
                        for (int i = 0; i < 2; ++i) { R.ba[i] = *(const u32x4*)(pr + PC_KB + i * 512 + lane * 8); R.bb[i] = *(const u32x4*)(pr + PC_VB + i * 512 + lane * 8); } }
                    const int j0 = (lane & 7) * 4;
                    const float* tp = rope + ((size_t)pos * 32 + j0) * 2; R.t0 = *(const f32x4*)tp; R.t1 = *(const f32x4*)(tp + 4);
                    R.wq = *(const u32x4*)(pr + PC_QR + lane * 8); R.wk = *(const u32x4*)(pr + PC_KRR + lane * 8);
                    return R; };
              auto row_finish = [&](const int job, RowIn& R) __attribute__((always_inline)) {
                    const int rr = job, ar = gr.xr0 + rr, pos = row_pos(ar), kvr = row_kv(ar) - gr.kv0; bf16_t* pr = proj + (size_t)rr * NPROJ;
                    const bool isp = ar < MP; const bool bandc = !isp || (ar & (TT - 1)) >= TT - 512; const int hh = lane >> 3;
                    { const u32x4 w = R.wcq; float ss = bf_lo(w.x) * bf_lo(w.x) + bf_hi(w.x) * bf_hi(w.x) + bf_lo(w.y) * bf_lo(w.y) + bf_hi(w.y) * bf_hi(w.y)
                          + bf_lo(w.z) * bf_lo(w.z) + bf_hi(w.z) * bf_hi(w.z) + bf_lo(w.w) * bf_lo(w.w) + bf_hi(w.w) * bf_hi(w.w);
                      ss = wave_sum(ss); if (lane == 0) sqv[ar] = rsqrtf(ss * (1.0f / 512.0f) + EPS); }
                    { const u32x2 w = R.wkv; const float x0 = bf_lo(w.x), x1 = bf_hi(w.x), x2 = bf_lo(w.y), x3 = bf_hi(w.y);
                      float ss = wave_sum(x0 * x0 + x1 * x1 + x2 * x2 + x3 * x3); const float rs = rsqrtf(ss * (1.0f / 256.0f) + EPS);
                      const f32x4 y = {x0 * rs * gk[0], x1 * rs * gk[1], x2 * rs * gk[2], x3 * rs * gk[3]};
                      float* o = isp ? out + O_CKV_P + ((size_t)l * MP + ar) * 256 : out + O_CKV_S + ((size_t)l * MS + (ar - MP)) * 256; *(f32x4*)(o + lane * 4) = y;
                      *(u32x2*)(ckva + (size_t)kvr * 256 + lane * 4) = (u32x2){cvt_pk_bf16(y[0], y[1]), cvt_pk_bf16(y[2], y[3])}; }
                    if (lane < 32) { const float x1 = bf_lo(R.wkr), x2 = bf_hi(R.wkr);
                      const float o1 = x1 * R.csr.x - x2 * R.csr.y, o2 = x2 * R.csr.x + x1 * R.csr.y;
                      float* o = isp ? out + O_KR_P + ((size_t)l * MP + ar) * 64 : out + O_KR_S + ((size_t)l * MS + (ar - MP)) * 64; o[lane] = o1; o[32 + lane] = o2;
                      *(unsigned*)(kropa + (size_t)kvr * 64 + 2 * lane) = cvt_pk_bf16(o1, o2); }
                    if (bandc) { float* ok; float* ov;
                      if (!isp) { ok = out + O_BK_S + ((size_t)l * MS + (ar - MP)) * 1024; ov = out + O_BV_S + ((size_t)l * MS + (ar - MP)) * 1024; }
                      else { const size_t idx = (((size_t)l * NB + (ar >> 13)) * 512 + ((ar & (TT - 1)) - (TT - 512))) * 1024; ok = out + O_BK_P + idx; ov = out + O_BV_P + idx; }
#pragma unroll
                      for (int i = 0; i < 2; ++i) { const u32x4 a = R.ba[i], b = R.bb[i];
                          *(f32x4*)(ok + i * 512 + lane * 8) = (f32x4){bf_lo(a.x), bf_hi(a.x), bf_lo(a.y), bf_hi(a.y)}; *(f32x4*)(ok + i * 512 + lane * 8 + 4) = (f32x4){bf_lo(a.z), bf_hi(a.z), bf_lo(a.w), bf_hi(a.w)};
                          *(f32x4*)(ov + i * 512 + lane * 8) = (f32x4){bf_lo(b.x), bf_hi(b.x), bf_lo(b.y), bf_hi(b.y)}; *(f32x4*)(ov + i * 512 + lane * 8 + 4) = (f32x4){bf_lo(b.z), bf_hi(b.z), bf_lo(b.w), bf_hi(b.w)}; } }
                    { const float lg = lg2_gamma(hh); const int ic = isp ? (pos & 63) : (pos - PAST); const int L = isp ? 64 : ST;
                      const float qs = __builtin_amdgcn_exp2f((float)(ic + 1) * lg - 3.0f), ks = __builtin_amdgcn_exp2f((float)(L - 1 - ic) * lg);
                      const f32x4 t0 = R.t0, t1 = R.t1; u32x4 wq = R.wq, wk = R.wk;
#define ROT(W, C, S_, SC) cvt_pk_bf16((bf_lo(W) * (C) - bf_hi(W) * (S_)) * (SC), (bf_hi(W) * (C) + bf_lo(W) * (S_)) * (SC))
                      wq.x = ROT(wq.x, t0[0], t0[1], qs); wq.y = ROT(wq.y, t0[2], t0[3], qs); wq.z = ROT(wq.z, t1[0], t1[1], qs); wq.w = ROT(wq.w, t1[2], t1[3], qs);
                      wk.x = ROT(wk.x, t0[0], t0[1], ks); wk.y = ROT(wk.y, t0[2], t0[3], ks); wk.z = ROT(wk.z, t1[0], t1[1], ks); wk.w = ROT(wk.w, t1[2], t1[3], ks);
#undef ROT
                      *(u32x4*)(pr + PC_QR + lane * 8) = wq; *(u32x4*)(pr + PC_KRR + lane * 8) = wk; } };
              for (int job = bid * 8 + wave; job < njobs; job += G * 16) {
                  const int job2 = job + G * 8; const bool two = job2 < njobs;
                  RowIn RA = row_load(job); RowIn RB = row_load(two ? job2 : job);
                  row_finish(job, RA); if (two) row_finish(job2, RB);
              }
              if (gr.samp) { const int ncj = SB * PAST;
                for (int cj0 = bid * 8 + wave; cj0 < ncj; cj0 += G * 32) {
                    f32x4 cvv[4]; float k0v[4], k1v[4];
#pragma unroll
                    for (int e = 0; e < 4; ++e) { const int cjj = cj0 + e * G * 8; const int cj = cjj < ncj ? cjj : cj0; const int b = cj >> 10, t = cj & 1023;
                        cvv[e] = *(const f32x4*)(INP(4) + (((size_t)l * SB + b) * PAST + t) * 256 + lane * 4);
                        const float* ks = INP(5) + (((size_t)l * SB + b) * PAST + t) * 64; k0v[e] = ks[lane & 31]; k1v[e] = ks[32 + (lane & 31)]; }
#pragma unroll
                    for (int e = 0; e < 4; ++e) { const int cj = cj0 + e * G * 8; if (cj < ncj) { const int b = cj >> 10, t = cj & 1023; const int kvr = MP + b * KVS + t - gr.kv0;
                        *(u32x2*)(ckva + (size_t)kvr * 256 + lane * 4) = (u32x2){cvt_pk_bf16(cvv[e][0], cvv[e][1]), cvt_pk_bf16(cvv[e][2], cvv[e][3])};
                        if (lane < 32) *(unsigned*)(kropa + (size_t)kvr * 64 + 2 * lane) = cvt_pk_bf16(k0v[e], k1v[e]); } }
                } } }
            PH_END

            PH_BEGIN(4)
            {
              { const int tid = opaque_tid(wave_s); pg8::Gemm gm{proj + PC_CQ, wt + WT_UQ, gr.nxr, 1536, 512, NPROJ, 512}; pg8::StaticOrder S; S.init(gm.M, gm.N, G, bid);
                EpiQ E{qbuf, sqv, rope, gr.xr0}; pg8::gemm_phase<EpiQ>(tid, lds, gm, S, E); }
              { const int tid = opaque_tid(wave_s); pg8::Gemm gm{ckva, wt + WT_UK, gr.nkv, 1024, 256, 256, 256}; pg8::StaticOrder S; S.init(gm.M, gm.N, G, (bid + 136) % G);
                EpiPlain<1024> E{knope}; pg8::gemm_phase<EpiPlain<1024>>(tid, lds, gm, S, E); }
              { const int tid = opaque_tid(wave_s); pg8::Gemm gm{wt + WT_UV, ckva, 1024, gr.nkv, 256, 256, 256}; pg8::StaticOrder S; S.init(gm.M, gm.N, G, (bid + 72) % G);
                EpiPlain<VT_LD> E{vtb}; pg8::gemm_phase<EpiPlain<VT_LD>>(tid, lds, gm, S, E); }
              __syncthreads();
              { const int tid = opaque_tid(wave_s); const int lane = tid & 63; const int nun = GNB * 8 * 128;
                  const int uqu = (gr.nxr / 256) * 6, nl = uqu - G, nh = G - nl; const bool bal = nl > 0 && nh > 0 && 6 * G <= nun;
#define RET_UNIT(k) (!bal ? (((bid + 200) % G + (k) * G) < nun ? ((bid + 200) % G + (k) * G) : -1) : ((k) < 6 ? bid + G * (k) : (bid < nl ? -1 : ((6 * G + (bid - nl) + nh * ((k) - 6)) < nun ? (6 * G + (bid - nl) + nh * ((k) - 6)) : -1))))
                  int k = 0; int u = RET_UNIT(0); int buf = 0; RetRegs R = ret_fetch(tid, proj, 0, 0, false);
                  if (u >= 0) R = ret_fetch(tid, proj + (size_t)((u >> 10) * TT + (u & 127) * 64) * NPROJ, 64, (u >> 7) & 7, false);
                  while (u >= 0) { LAS unsigned char* lb = lds + buf * RT_BUF;
                      ret_put(tid, lb, R, false);
                      __syncthreads();
                      const int un = RET_UNIT(k + 1); if (un >= 0) R = ret_fetch(tid, proj + (size_t)((un >> 10) * TT + (un & 127) * 64) * NPROJ, 64, (un >> 7) & 7, false);
                      const int eb = wave & 3, dbk = wave >> 2; const f32x16 acc = ret_state(tid, lb, eb, dbk);
                      bf16_t* dst = rets + (size_t)u * 8192 + (32 * dbk + (lane & 31));
#pragma unroll
                      for (int r = 0; r < 16; r += 2) {
                          const bool odd = lane & 1; const float mine = odd ? acc[r + 1] : acc[r], send = odd ? acc[r] : acc[r + 1];
                          const float recv = __int_as_float(__builtin_amdgcn_mov_dpp(__float_as_int(send), 0xB1, 0xF, 0xF, false));
                          const unsigned w = odd ? cvt_pk_bf16(recv, mine) : cvt_pk_bf16(mine, recv);
                          const int rq = odd ? r + 1 : r;
                          *(unsigned*)(dst - (lane & 1) + (size_t)(32 * eb + (rq & 3) + 8 * (rq >> 2) + 4 * (lane >> 5)) * 64) = w; }
                      buf ^= 1; u = un; ++k; }
#undef RET_UNIT
              } }
            PH_END

            PH_BEGIN(5)
            { const int n_mla = GNB * 8 * 16, n_band = GNB * 8 * 32, n_scan = GNB * 8 * 16, n_smp = gr.samp ? SB * 8 : 0;
              const int n_items = n_mla + n_band + n_scan + 2 * n_smp;
              const int bx = ((G & 7) == 0 && n_mla % G == 0 && n_band % G == 0) ? (bid & 7) * (G >> 3) + (bid >> 3) : bid;
              const int l31 = lane & 31;
              for (int it = bid; it < n_items; it += G) {
                if (it < n_mla) {
                    const int itx = it - bid + bx;
                    const int x = itx & 15, h = (itx >> 4) & 7, bl = itx >> 7;
                    MlaLoader L; L.tid = tid; L.kn = (const char*)(knope + (size_t)(bl * TT) * 1024 + h * 128); L.kr = (const char*)(kropa + (size_t)(bl * TT) * 64); L.vt = (const char*)(vtb + (size_t)(h * 128) * VT_LD + bl * TT); L.nkeys = TT;
#pragma unroll 1
                    for (int pass = 0; pass < 2; ++pass) { const int qb = (pass & 1) == 0 ? x : 31 - x; const int rr = bl * TT + qb * 256 + wave * 32 + l31; const int cw = 4 * qb + (wave >> 1);
                        attn_unit<192, false, MlaLoader>(tid, lds, L, qbuf + (size_t)rr * 1536 + h * 192, true, 0, 4 * qb + 4, 0, cw + 1, TT, 0, 0, ocat + (size_t)rr * 3072 + h * 128); }
                } else if (it < n_mla + n_band) {
                    const int u = it - n_mla - bid + bx, qb = u & 31, h = (u >> 5) & 7, bl = u >> 8;
                    __syncthreads();
                    { LAS float* bt = (LAS float*)(lds + AT_BIAS); if (tid < 257) bt[tid] = INP(17)[((size_t)l * 8 + h) * 257 + tid] * LOG2E; }
                    BandLoader L; L.tid = tid; L.kc = nullptr; L.vc = nullptr; L.ncache = 0; L.kp = (const char*)(proj + (size_t)(bl * TT) * NPROJ + PC_KB + h * 128); L.vp = (const char*)(proj + (size_t)(bl * TT) * NPROJ + PC_VB + h * 128); L.nkeys = TT;
                    const int rr = bl * TT + qb * 256 + wave * 32 + l31; const int cw = 4 * qb + (wave >> 1); const int t0 = (4 * qb - 8) > 0 ? (4 * qb - 8) : 0, wt0 = (cw - 8) > 0 ? (cw - 8) : 0;
                    attn_unit<128, true, BandLoader>(tid, lds, L, proj + (size_t)rr * NPROJ + PC_QB + h * 128, true, t0, 4 * qb + 4, wt0, cw + 1, TT, qb * 256 + wave * 32 + l31, 0, ocat + (size_t)rr * 3072 + 1024 + h * 128);
                } else if (it < n_mla + n_band + n_scan) {
                    const int u = it - n_mla - n_band, sl = u & 15, h = (u >> 4) & 7, bl = u >> 7; const int idx = sl * 512 + tid;
                    const bf16_t* p = rets + (size_t)((bl * 8 + h) * 128) * 8192 + idx; bf16_t* pb = retb + (size_t)((bl * 8 + h) * 128) * 8192 + idx; const float g64 = __builtin_amdgcn_exp2f(64.0f * lg2_gamma(h)); float run = 0.f;
                    float v[32];
#pragma unroll
                    for (int j = 0; j < 32; ++j) v[j] = __uint_as_float((unsigned)p[(size_t)j * 8192] << 16);
#pragma unroll 1
                    for (int c = 0; c < 128; c += 32) { float vn[32]; const int cn = c + 32 < 128 ? c + 32 : c;
#pragma unroll
                        for (int j = 0; j < 32; ++j) vn[j] = __uint_as_float((unsigned)p[(size_t)(cn + j) * 8192] << 16);
#pragma unroll
                        for (int j = 0; j < 32; j += 2) {
                            const float r0 = run; run = g64 * run + v[j]; const float r1 = run; run = g64 * run + v[j + 1];
                            const bool odd = lane & 1; const float mine = odd ? r1 : r0, send = odd ? r0 : r1;
                            const float recv = __int_as_float(__builtin_amdgcn_mov_dpp(__float_as_int(send), 0xB1, 0xF, 0xF, false));
                            const unsigned w = odd ? cvt_pk_bf16(recv, mine) : cvt_pk_bf16(mine, recv);
                            *(unsigned*)(pb - (lane & 1) + (size_t)(c + j + (odd ? 1 : 0)) * 8192) = w; }
#pragma unroll
                        for (int j = 0; j < 32; ++j) v[j] = vn[j]; }
                    const int e = idx >> 6, d = idx & 63;
                    out[O_RET_P + ((((size_t)l * NB + gr.b0 + bl) * 8 + h) * 64 + ((d & 1) * 32 + (d >> 1))) * 128 + e] = run;
                } else if (it < n_mla + n_band + n_scan + n_smp) {
                    const int u = it - n_mla - n_band - n_scan, h = u & 7, b = u >> 3;
                    const int kvb = MP + b * KVS - gr.kv0; MlaLoader L; L.tid = tid; L.kn = (const char*)(knope + (size_t)kvb * 1024 + h * 128); L.kr = (const char*)(kropa + (size_t)kvb * 64); L.vt = (const char*)(vtb + (size_t)(h * 128) * VT_LD + kvb); L.nkeys = KVS;
                    const int qi = l31 < 16 ? l31 : 15; const int rr = MP + b * ST + qi - gr.xr0;
                    attn_unit<192, false, MlaLoader>(tid, lds, L, qbuf + (size_t)rr * 1536 + h * 192, wave == 0, 0, 17, 0, 17, KVS, 0, 0, (wave == 0 && l31 < 16) ? ocat + (size_t)rr * 3072 + h * 128 : nullptr);
                } else {
                    const int u = it - n_mla - n_band - n_scan - n_smp, h = u & 7, b = u >> 3;
                    __syncthreads();
                    { LAS float* bt = (LAS float*)(lds + AT_BIAS); if (tid < 257) bt[tid] = INP(17)[((size_t)l * 8 + h) * 257 + tid] * LOG2E; }
                    const int r0 = MP + b * ST - gr.xr0;
                    BandLoader L; L.tid = tid; L.kc = (const char*)(INP(6) + (((size_t)l * SB + b) * 512) * 1024 + h * 128); L.vc = (const char*)(INP(7) + (((size_t)l * SB + b) * 512) * 1024 + h * 128); L.ncache = 512;
                    L.kp = (const char*)(proj + (size_t)r0 * NPROJ + PC_KB + h * 128); L.vp = (const char*)(proj + (size_t)r0 * NPROJ + PC_VB + h * 128); L.nkeys = 528;
                    const int qi = l31 < 16 ? l31 : 15; const int rr = r0 + qi;
                    attn_unit<128, true, BandLoader>(tid, lds, L, proj + (size_t)rr * NPROJ + PC_QB + h * 128, wave == 0, 0, 9, 0, 9, 528, PAST + qi, 512, (wave == 0 && l31 < 16) ? ocat + (size_t)rr * 3072 + 1024 + h * 128 : nullptr);
                }
              } }
            PH_END

            PH_BEGIN(6)
            { const int n_p = GNB * 8 * 128, n_s = gr.samp ? SB * 8 : 0;
              const int eb = wave & 3, qbk = wave >> 2, l31 = lane & 31;
              { int it = bid; int buf = 0; RetRegs R = ret_fetch(tid, proj, 0, 0, false);
                const unsigned spo = (unsigned)((32 * eb + l31) * 64 + 8 * (lane >> 5)) * 2u;
                u32x4 sr[4];
                { const char* sp = (const char*)(retb + (size_t)(it < n_p ? it : 0) * 8192) + spo;
#pragma unroll
                  for (int ks = 0; ks < 4; ++ks) sr[ks] = *(const u32x4*)(sp + 32 * ks); }
                if (it < n_p) R = ret_fetch(tid, proj + (size_t)((it >> 10) * TT + (it & 127) * 64) * NPROJ, 64, (it >> 7) & 7, true);
                for (; it < n_p; it += G) { const int c = it & 127, h = (it >> 7) & 7, bl = it >> 10; const int r0 = bl * TT + c * 64; LAS unsigned char* lb = lds + buf * RT_BUF;
                    ret_put(tid, lb, R, true);
                    __syncthreads();
                    const int un = it + G;
                    if (un < n_p) R = ret_fetch(tid, proj + (size_t)((un >> 10) * TT + (un & 127) * 64) * NPROJ, 64, (un >> 7) & 7, true);
                    const float ginvL = __builtin_amdgcn_exp2f(-64.0f * lg2_gamma(h));
                    bf16x8 sf[4];
#pragma unroll
                    for (int ks = 0; ks < 4; ++ks) { u32x4 w = sr[ks]; sf[ks] = *reinterpret_cast<bf16x8*>(&w); }
                    { const char* sp = (const char*)(retb + (size_t)(un < n_p ? un : it) * 8192) + spo;
#pragma unroll
                      for (int ks = 0; ks < 4; ++ks) sr[ks] = *(const u32x4*)(sp + 32 * ks); }
                    const f32x16 acc = ret_out(tid, lb, eb, qbk, ginvL, sf);
                    const int rr = r0 + 32 * qbk + l31;
                    ret_finish(lb, acc, eb, qbk, INP(18) + l * 1024 + h * 128, proj + (size_t)rr * NPROJ + PC_GR + h * 128, ocat + (size_t)rr * 3072 + 2048 + h * 128, tid);
                    buf ^= 1; }
                __syncthreads(); }
              for (int it = n_p + bid; it < n_p + n_s; it += G) {
                {
                  const int u = it - n_p, h = u & 7, b = u >> 3; const int r0 = MP + b * ST - gr.xr0;
                    ret_load(tid, lds, proj + (size_t)r0 * NPROJ, ST, h, true);
                    __syncthreads();
                    const float* sp = INP(8) + (((size_t)l * SB + b) * 8 + h) * 8192;
                    const float lg = lg2_gamma(h); const float ginvL = __builtin_amdgcn_exp2f(-16.0f * lg), g16 = __builtin_amdgcn_exp2f(16.0f * lg);
                    { const f32x16 kc = ret_state(tid, lds, wave & 3, wave >> 2); const int d = 32 * (wave >> 2) + l31; float* o = out + O_RET_S + (((size_t)l * SB + b) * 8 + h) * 8192;
#pragma unroll
                      for (int r = 0; r < 16; ++r) { const int e = 32 * (wave & 3) + (r & 3) + 8 * (r >> 2) + 4 * (lane >> 5); const int dor = (d & 1) * 32 + (d >> 1); o[dor * 128 + e] = g16 * sp[dor * 128 + e] + kc[r]; } }
                    bf16x8 sf[4];
#pragma unroll
                    for (int ks = 0; ks < 4; ++ks) { float v[8]; const int e = 32 * eb + l31, d0 = 16 * ks + 8 * (lane >> 5);
#pragma unroll
                        for (int j = 0; j < 8; ++j) v[j] = sp[(((d0 + j) & 1) * 32 + ((d0 + j) >> 1)) * 128 + e];
                        u32x4 w = {cvt_pk_bf16(v[0], v[1]), cvt_pk_bf16(v[2], v[3]), cvt_pk_bf16(v[4], v[5]), cvt_pk_bf16(v[6], v[7])}; sf[ks] = *reinterpret_cast<bf16x8*>(&w); }
                    const f32x16 acc = ret_out(tid, lds, eb, qbk, ginvL, sf);
                    const bool ok = (qbk == 0 && l31 < ST); const int rr = r0 + (ok ? l31 : 0);
                    ret_finish(lds, acc, eb, qbk, INP(18) + l * 1024 + h * 128, proj + (size_t)rr * NPROJ + PC_GR + h * 128, ok ? ocat + (size_t)rr * 3072 + 2048 + h * 128 : nullptr, tid);
                    __syncthreads();
                }
              } }
            PH_END

            PH_BEGIN(7)
            { pg8::Gemm gm{ocat, wt + WT_P, GPR, 2048, 3072, 3072, 3072}; pg8::StaticOrder S; S.init(gm.M, gm.N, G, bid);
              EpiMerge E{merged, gatebuf}; pg8::gemm_phase<EpiMerge>(tid, lds, gm, S, E); }
            if (gr.samp) { const int tid = opaque_tid(wave_s); const int w = __builtin_amdgcn_readfirstlane(tid >> 6);
              const int br = w < 3 ? 0 : (w < 6 ? 1 : 2), wi = w - 3 * br; const int kch0 = br < 2 ? 16 * br + (wi == 0 ? 0 : (wi == 1 ? 6 : 11)) : 32 + 8 * wi, nc = br < 2 ? (wi == 0 ? 6 : 5) : 8;
              skinny_tiles(tid, lds, ocat + (size_t)GPR * 3072, 3072, wt + WT_P, 3072, kch0, nc, G, bid, SkMergePre{gatebuf, br}, SkMergeFin{merged}); }
            PH_END

            PH_BEGIN(8)
            { pg8::Gemm gm{merged, wt + WT_O, GPR, 2048, 2048, 2048, 2048}; pg8::StaticOrder S; S.init(gm.M, gm.N, G, bid);
              EpiGate E{hbuf, adal + 2 * DM, gr.xr0}; pg8::gemm_phase<EpiGate>(tid, lds, gm, S, E); }
            if (gr.samp) { const int tid = opaque_tid(wave_s); const int w = __builtin_amdgcn_readfirstlane(tid >> 6);
              skinny_tiles(tid, lds, merged + (size_t)GPR * 2048, 2048, wt + WT_O, 2048, w * 4, 4, G, bid, SkNoPre{}, SkGateFin{hbuf, adal + 2 * DM}); }
            PH_END
        }

        PH_BEGIN(9)
        { f32x4 gg[8], bb[8];
#define LNC(i_) (((i_) >> 1) * 512 + lane * 8 + ((i_) & 1) * 4)
#pragma unroll
        for (int i = 0; i < 8; ++i) { const int c = LNC(i); gg[i] = *(const f32x4*)(INP(23) + l * DM + c); bb[i] = *(const f32x4*)(INP(24) + l * DM + c); }
        f32x4 sh[8], sc[8]; int cst = -1;
#pragma unroll
        for (int i = 0; i < 8; ++i) { sh[i] = gg[i]; sc[i] = gg[i]; }
        for (int ar = bid * 8 + wave; ar < MX; ar += G * 8) { bf16_t* xr = xbuf + (size_t)ar * DM; f32x4 v[8]; float s = 0.f;
            const float* xs = ar < MP ? INP(0) + (size_t)ar * DM : INP(1) + (size_t)(ar - MP) * DM; const bf16_t* vb = hbuf + (size_t)ar * DM; const int st = row_stream(ar); const float* a = adal + (size_t)st * NADA;
#pragma unroll
            for (int j = 0; j < 4; ++j) { const int c0 = j * 512 + lane * 8; f32x4 x0, x1;
                if (l == 0) { x0 = *(const f32x4*)(xs + c0); x1 = *(const f32x4*)(xs + c0 + 4); }
                else { const u32x4 xw = *(const u32x4*)(xr + c0); x0 = (f32x4){bf_lo(xw.x), bf_hi(xw.x), bf_lo(xw.y), bf_hi(xw.y)}; x1 = (f32x4){bf_lo(xw.z), bf_hi(xw.z), bf_lo(xw.w), bf_hi(xw.w)}; }
                const u32x4 w = *(const u32x4*)(vb + c0);
                v[2 * j] = x0 * ALPHA + (f32x4){bf_lo(w.x), bf_hi(w.x), bf_lo(w.y), bf_hi(w.y)}; v[2 * j + 1] = x1 * ALPHA + (f32x4){bf_lo(w.z), bf_hi(w.z), bf_lo(w.w), bf_hi(w.w)};
                s += ((v[2 * j][0] + v[2 * j][1]) + (v[2 * j][2] + v[2 * j][3])) + ((v[2 * j + 1][0] + v[2 * j + 1][1]) + (v[2 * j + 1][2] + v[2 * j + 1][3])); }
            if (st != cst) { cst = st;
#pragma unroll
                for (int i = 0; i < 8; ++i) { const int c = LNC(i); sh[i] = *(const f32x4*)(a + 3 * DM + c); sc[i] = *(const f32x4*)(a + 4 * DM + c); } }
            const float mean = wave_sum(s) * (1.0f / DM); float q = 0.f;
#pragma unroll
            for (int i = 0; i < 8; ++i) { const f32x4 d = v[i] - mean; q += (d[0] * d[0] + d[1] * d[1]) + (d[2] * d[2] + d[3] * d[3]); }
            const float rstd = rsqrtf(wave_sum(q) * (1.0f / DM) + EPS);
#pragma unroll
            for (int j = 0; j < 4; ++j) { const int c0 = j * 512 + lane * 8;
                const f32x4 y0 = (v[2 * j] - mean) * rstd * gg[2 * j] + bb[2 * j], y1 = (v[2 * j + 1] - mean) * rstd * gg[2 * j + 1] + bb[2 * j + 1];
                *(u32x4*)(xr + c0) = (u32x4){cvt_pk_bf16(y0[0], y0[1]), cvt_pk_bf16(y0[2], y0[3]), cvt_pk_bf16(y1[0], y1[1]), cvt_pk_bf16(y1[2], y1[3])};
                const f32x4 h0 = y0 * (sc[2 * j] + 1.0f) + sh[2 * j], h1 = y1 * (sc[2 * j + 1] + 1.0f) + sh[2 * j + 1];
                *(u32x4*)(hbuf + (size_t)ar * DM + c0) = (u32x4){cvt_pk_bf16(h0[0], h0[1]), cvt_pk_bf16(h0[2], h0[3]), cvt_pk_bf16(h1[0], h1[1]), cvt_pk_bf16(h1[2], h1[3])}; } } }
        PH_END

        PH_BEGIN(10)
        { pg8::Gemm gm{hbuf, wt + WT_FAB, MX, NFAB, 2048, 2048, 2048}; pg8::StaticOrder S; S.init(gm.M, gm.N, G, bid);
          EpiConv E{ubuf, sidebuf, INP(27) + (size_t)l * 3 * DFF, INP(28) + (size_t)l * DFF}; pg8::gemm_phase<EpiConv>(tid, lds, gm, S, E); }
        PH_END

        PH_BEGIN(11)
        { const int ngrp = MP / 64 + MS / 16;
          for (int it = bid * 512 + tid; it < ngrp * (DFF / 8); it += G * 512) { const int gq = it / (DFF / 8), c = (it % (DFF / 8)) * 8;
            const bool isp = gq < MP / 64; const int r0 = isp ? gq * 64 : MP + (gq - MP / 64) * 16; const int gi = r0 >> 4;
            const bool seqstart = isp ? ((r0 & (TT - 1)) == 0) : true;
            float am2[8], am1[8], a0[8], a1[8], b0[8], b1[8];
#define LD8(dst, p) { const u32x4 w_ = *(const u32x4*)(p); dst[0] = bf_lo(w_.x); dst[1] = bf_hi(w_.x); dst[2] = bf_lo(w_.y); dst[3] = bf_hi(w_.y); dst[4] = bf_lo(w_.z); dst[5] = bf_hi(w_.z); dst[6] = bf_lo(w_.w); dst[7] = bf_hi(w_.w); }
            if (seqstart) { if (isp) {
#pragma unroll
                    for (int j = 0; j < 8; ++j) { am2[j] = 0.f; am1[j] = 0.f; } }
                else { const float* sc = INP(9) + (((size_t)l * SB + ((r0 - MP) >> 4)) * 2) * DFF + c;
#pragma unroll
                    for (int j = 0; j < 8; ++j) { am2[j] = sc[j]; am1[j] = sc[DFF + j]; } } }
            else { const bf16_t* pp = sidebuf + (size_t)(gi - 1) * 6 * DFF + c; LD8(am2, pp + 4 * DFF); LD8(am1, pp + 5 * DFF); }
            const bf16_t* sp = sidebuf + (size_t)gi * 6 * DFF + c; LD8(a0, sp); LD8(a1, sp + DFF); LD8(b0, sp + 2 * DFF); LD8(b1, sp + 3 * DFF);
            f32x4 w0v[2], w1v[2], w2v[2], cbq[2];
#pragma unroll
            for (int q = 0; q < 2; ++q) { w0v[q] = *(const f32x4*)(INP(27) + ((size_t)l * 3 + 0) * DFF + c + 4 * q); w1v[q] = *(const f32x4*)(INP(27) + ((size_t)l * 3 + 1) * DFF + c + 4 * q);
                w2v[q] = *(const f32x4*)(INP(27) + ((size_t)l * 3 + 2) * DFF + c + 4 * q); cbq[q] = *(const f32x4*)(INP(28) + (size_t)l * DFF + c + 4 * q); }
            float u0[8], u1[8];
#pragma unroll
            for (int j = 0; j < 8; ++j) { const float cw0 = w0v[j >> 2][j & 3], cw1 = w1v[j >> 2][j & 3], cw2 = w2v[j >> 2][j & 3], cbv = cbq[j >> 2][j & 3];
                u0[j] = gelu1(cbv + am2[j] * cw0 + am1[j] * cw1 + a0[j] * cw2) * b0[j]; u1[j] = gelu1(cbv + am1[j] * cw0 + a0[j] * cw1 + a1[j] * cw2) * b1[j]; }
            *(u32x4*)(ubuf + (size_t)r0 * DFF + c) = (u32x4){cvt_pk_bf16(u0[0], u0[1]), cvt_pk_bf16(u0[2], u0[3]), cvt_pk_bf16(u0[4], u0[5]), cvt_pk_bf16(u0[6], u0[7])};
            *(u32x4*)(ubuf + (size_t)(r0 + 1) * DFF + c) = (u32x4){cvt_pk_bf16(u1[0], u1[1]), cvt_pk_bf16(u1[2], u1[3]), cvt_pk_bf16(u1[4], u1[5]), cvt_pk_bf16(u1[6], u1[7])};
            const bool seqend = isp ? (((r0 + 64) & (TT - 1)) == 0) : true;
            if (seqend) { const int gl = isp ? gi + 3 : gi; const bf16_t* lp = sidebuf + (size_t)gl * 6 * DFF + c; float e0[8], e1[8]; LD8(e0, lp + 4 * DFF); LD8(e1, lp + 5 * DFF);
                float* o = isp ? out + O_CONV_P + (((size_t)l * NB + (r0 >> 13)) * 2) * DFF + c : out + O_CONV_S + (((size_t)l * SB + ((r0 - MP) >> 4)) * 2) * DFF + c;
#pragma unroll
                for (int j = 0; j < 8; ++j) { o[j] = e0[j]; o[DFF + j] = e1[j]; } }
#undef LD8
          } }
        PH_END

        PH_BEGIN(12)
        { pg8::Gemm gm{ubuf, wt + WT_FD, MP, 2048, DFF, DFF, DFF}; pg8::StaticOrder S; S.init(gm.M, gm.N, G, bid);
          EpiGate E{hbuf, adal + 5 * DM, 0}; pg8::gemm_phase<EpiGate>(tid, lds, gm, S, E); }
        { const int tid = opaque_tid(wave_s); const int w = __builtin_amdgcn_readfirstlane(tid >> 6);
          skinny_tiles(tid, lds, ubuf + (size_t)MP * DFF, DFF, wt + WT_FD, DFF, w * 11, 11, G, bid, SkNoPre{}, SkGateFin{hbuf, adal + 5 * DM}); }
        PH_END

        PH_BEGIN(13)
        { const float* adan = ada + (size_t)NSTREAM * NADA;
          f32x4 gg[8], bb[8];
#pragma unroll
          for (int i = 0; i < 8; ++i) { const int c = LNC(i); gg[i] = *(const f32x4*)(INP(30) + l * DM + c); bb[i] = *(const f32x4*)(INP(31) + l * DM + c); }
          f32x4 sh[8], sc[8]; int cst = -1;
#pragma unroll
          for (int i = 0; i < 8; ++i) { sh[i] = gg[i]; sc[i] = gg[i]; }
          for (int ar = bid * 8 + wave; ar < MX; ar += G * 8) { bf16_t* xr = xbuf + (size_t)ar * DM; float* yo = out + O_Y + (size_t)ar * DM; f32x4 v[8]; float s = 0.f; const bf16_t* vb = hbuf + (size_t)ar * DM;
            const int st = row_stream(ar); const float* a = adan + (size_t)st * NADA;
#pragma unroll
            for (int j = 0; j < 4; ++j) { const int c0 = j * 512 + lane * 8; const u32x4 xw = *(const u32x4*)(xr + c0), w = *(const u32x4*)(vb + c0);
                v[2 * j] = (f32x4){bf_lo(xw.x), bf_hi(xw.x), bf_lo(xw.y), bf_hi(xw.y)} * ALPHA + (f32x4){bf_lo(w.x), bf_hi(w.x), bf_lo(w.y), bf_hi(w.y)};
                v[2 * j + 1] = (f32x4){bf_lo(xw.z), bf_hi(xw.z), bf_lo(xw.w), bf_hi(xw.w)} * ALPHA + (f32x4){bf_lo(w.z), bf_hi(w.z), bf_lo(w.w), bf_hi(w.w)};
                s += ((v[2 * j][0] + v[2 * j][1]) + (v[2 * j][2] + v[2 * j][3])) + ((v[2 * j + 1][0] + v[2 * j + 1][1]) + (v[2 * j + 1][2] + v[2 * j + 1][3])); }
            if (l == 0 && st != cst) { cst = st;
#pragma unroll
                for (int i = 0; i < 8; ++i) { const int c = LNC(i); sh[i] = *(const f32x4*)(a + c); sc[i] = *(const f32x4*)(a + DM + c); } }
            const float mean = wave_sum(s) * (1.0f / DM); float q = 0.f;
#pragma unroll
            for (int i = 0; i < 8; ++i) { const f32x4 d = v[i] - mean; q += (d[0] * d[0] + d[1] * d[1]) + (d[2] * d[2] + d[3] * d[3]); }
            const float rstd = rsqrtf(wave_sum(q) * (1.0f / DM) + EPS);
#pragma unroll
            for (int j = 0; j < 4; ++j) { const int c0 = j * 512 + lane * 8;
                const f32x4 y0 = (v[2 * j] - mean) * rstd * gg[2 * j] + bb[2 * j], y1 = (v[2 * j + 1] - mean) * rstd * gg[2 * j + 1] + bb[2 * j + 1];
                if (l == 0) { *(u32x4*)(xr + c0) = (u32x4){cvt_pk_bf16(y0[0], y0[1]), cvt_pk_bf16(y0[2], y0[3]), cvt_pk_bf16(y1[0], y1[1]), cvt_pk_bf16(y1[2], y1[3])};
                    const f32x4 h0 = y0 * (sc[2 * j] + 1.0f) + sh[2 * j], h1 = y1 * (sc[2 * j + 1] + 1.0f) + sh[2 * j + 1];
                    *(u32x4*)(hbuf + (size_t)ar * DM + c0) = (u32x4){cvt_pk_bf16(h0[0], h0[1]), cvt_pk_bf16(h0[2], h0[3]), cvt_pk_bf16(h1[0], h1[1]), cvt_pk_bf16(h1[2], h1[3])}; }
                else { *(f32x4*)(yo + c0) = y0; *(f32x4*)(yo + c0 + 4) = y1; } } }
          if (l == 0) { __syncthreads(); wconv_units(tid, pt, ws, lds, 1, bid * 8, G * 8); } }
        PH_END
    }
    }
#undef LNC
#undef PH_BEGIN
#undef PH_END
#undef adal
}

constexpr int N_PHASES = 2 + 2 * (NG * 7 + 5);

extern "C" void kernel_launch(void* const* d_in, const int* in_sizes, int n_in, void* d_out, int out_size, void* d_ws, size_t ws_size, hipStream_t stream) {
    static int grid = 0;
    if (grid == 0) {
        if (n_in != 32 || ws_size < WS_END) { fprintf(stderr, "kernel_launch: need 32 inputs and >= %zu bytes of workspace; got %d, %zu; nothing launched\n", (size_t)WS_END, n_in, ws_size); grid = -1; return; }
        int dev = 0, cus = 0, per_cu = 0;
        if (hipGetDevice(&dev) != hipSuccess || hipDeviceGetAttribute(&cus, hipDeviceAttributeMultiprocessorCount, dev) != hipSuccess) { grid = -1; return; }
        if (hipFuncSetAttribute((const void*)hse_fwd, hipFuncAttributeMaxDynamicSharedMemorySize, LDS_BYTES) != hipSuccess) { fprintf(stderr, "kernel_launch: hipFuncSetAttribute failed\n"); grid = -1; return; }
        if (hipOccupancyMaxActiveBlocksPerMultiprocessor(&per_cu, (const void*)hse_fwd, 512, LDS_BYTES) != hipSuccess || per_cu < 1) { fprintf(stderr, "kernel_launch: occupancy query says %d blocks per CU\n", per_cu); }
        (void)hipGetLastError();
        grid = cus;
    }
    if (grid < 0) return;
    (void)hipMemsetAsync((char*)d_ws + WS_CTL, 0, WS_CTL_BYTES, stream);
    Params p{};
    for (int i = 0; i < 32; ++i) p.in[i] = (const float*)d_in[i];
    p.out = (float*)d_out; p.ws = (unsigned char*)d_ws;
#if MK_ONE_LAUNCH
    p.ph_lo = 0; p.ph_hi = N_PHASES;
    hipLaunchKernelGGL(hse_fwd, dim3(grid), dim3(512), LDS_BYTES, stream, p);
#else
    for (int k = 0; k < N_PHASES; ++k) { p.ph_lo = k; p.ph_hi = k + 1; hipLaunchKernelGGL(hse_fwd, dim3(grid), dim3(512), LDS_BYTES, stream, p); }
#endif
}
```
